# Optimizing an MI355X kernel written in HIP

```python
import math
import jax, jax.numpy as jnp
from jax import lax
import numpy as np

D_MODEL = 1024
BATCH = 8
SEQ = 2048
DEPTH = 4
DEC_BATCH = 128
DEC_SEQ = 1
PAST_LEN = 16384
PAGE_SIZE = 128

GLA_WIDTH = D_MODEL // 2
N_HEADS_GLA = 4
HEAD_V = GLA_WIDTH // N_HEADS_GLA
HEAD_K = HEAD_V // 2
KEY_WIDTH = N_HEADS_GLA * HEAD_K
GATE_RANK = 16
GATE_TEMP = 16.0
GLA_CHUNK = 64
POOL_WIDTH = D_MODEL - GLA_WIDTH
POOL_WINDOWS = (2, 4, 8, 16)
N_POOL_GROUPS = len(POOL_WINDOWS)
POOL_GROUP = POOL_WIDTH // N_POOL_GROUPS
POOL_BUF = max(POOL_WINDOWS) - 1
D_FF = 4 * D_MODEL
IN_WIDTH = 2 * KEY_WIDTH + 2 * GLA_WIDTH + GATE_RANK + POOL_WIDTH
EPS = 1e-6

kernel_name = "hymba_gla_pool_decoder_step"


def rmsnorm(x, g):
    xf = x.astype(jnp.float32)
    y = xf * lax.rsqrt(jnp.mean(xf * xf, axis=-1, keepdims=True) + EPS)
    return (y * g.astype(jnp.float32)).astype(x.dtype)


def gla_chunked(q, k, v, log_a, s0):
    B, T, H, dk = q.shape
    dv = v.shape[-1]
    C = math.gcd(T, GLA_CHUNK)
    N = T // C
    f32 = jnp.float32
    rs = lambda t: t.reshape(B, N, C, H, t.shape[-1]).astype(f32)
    q, k, v, la = rs(q), rs(k), rs(v), rs(log_a)
    b = jnp.cumsum(la, axis=2)
    b_last = b[:, :, -1:]
    qt = q * jnp.exp(b) * (HEAD_K ** -0.5)
    kt = k * jnp.exp(-b)
    ke = k * jnp.exp(b_last - b)
    mask = jnp.tril(jnp.ones((C, C), dtype=bool))
    att = jnp.einsum('bnchk,bnshk->bnhcs', qt, kt)
    att = jnp.where(mask, att, 0.0)
    o_intra = jnp.einsum('bnhcs,bnshv->bnchv', att, v)
    decay = jnp.exp(b_last[:, :, 0])

    def step(S, xs):
        qn, ken, vn, dn = xs
        o = jnp.einsum('bchk,bhkv->bchv', qn, S)
        S = dn[..., None] * S + jnp.einsum('bchk,bchv->bhkv', ken, vn)
        return S, o

    mv = lambda t: jnp.moveaxis(t, 1, 0)
    s_fin, o_inter = lax.scan(step, s0.astype(f32), (mv(qt), mv(ke), mv(v), mv(decay)))
    o = o_intra + jnp.moveaxis(o_inter, 0, 1)
    return o.reshape(B, T, H, dv), s_fin


def pool_mix(u, prefix):
    ext = jnp.concatenate([prefix.astype(u.dtype), u], axis=1)
    B, L, Cw = ext.shape
    P = prefix.shape[1]
    T = u.shape[1]
    ef = ext.astype(jnp.float32)
    cs = jnp.concatenate([jnp.zeros((B, 1, Cw), jnp.float32), jnp.cumsum(ef, axis=1)], axis=1)
    w = jnp.repeat(jnp.array(POOL_WINDOWS, jnp.int32), POOL_GROUP)
    i = jnp.arange(P, L, dtype=jnp.int32)[:, None]
    lo = jnp.maximum(i - w[None, :] + 1, 0)
    s_lo = jnp.take_along_axis(cs, jnp.broadcast_to(lo[None], (B, T, Cw)), axis=1)
    s = cs[:, P + 1:L + 1] - s_lo
    count = (i + 1 - lo).astype(jnp.float32)
    out = s / count - ef[:, P:]
    return out, ext[:, L - POOL_BUF:]


def layer(x, s0, prefix, n1, w_in, w_gate, b_gate, gla_g, pool_w, pool_scale, w_out, n2, w_up, w_down):
    B, T, _ = x.shape
    h = rmsnorm(x, n1)
    z = h @ w_in
    c = np.cumsum([KEY_WIDTH, KEY_WIDTH, GLA_WIDTH, GLA_WIDTH, GATE_RANK])
    q, k, v, g, a_low, u = jnp.split(z, [int(t) for t in c], axis=-1)
    q = q.reshape(B, T, N_HEADS_GLA, HEAD_K)
    k = k.reshape(B, T, N_HEADS_GLA, HEAD_K)
    v = v.reshape(B, T, N_HEADS_GLA, HEAD_V)
    log_a = jax.nn.log_sigmoid((a_low @ w_gate + b_gate).astype(jnp.float32)) / GATE_TEMP
    log_a = log_a.reshape(B, T, N_HEADS_GLA, HEAD_K)
    o, s_new = gla_chunked(q, k, v, log_a, s0)
    o = o * lax.rsqrt(jnp.mean(o * o, axis=-1, keepdims=True) + EPS) * gla_g.astype(jnp.float32)
    o = o.reshape(B, T, GLA_WIDTH) * jax.nn.silu(g.astype(jnp.float32))
    p, buf = pool_mix(u, prefix)
    p = jnp.einsum('btgc,gcd->btgd', p.reshape(B, T, N_POOL_GROUPS, POOL_GROUP),
                   pool_w.astype(jnp.float32)).reshape(B, T, POOL_WIDTH)
    p = p * pool_scale.astype(jnp.float32)
    mix = jnp.concatenate([o, p], axis=-1).astype(x.dtype)
    x = x + mix @ w_out
    h2 = rmsnorm(x, n2)
    x = x + jnp.square(jax.nn.relu(h2 @ w_up)) @ w_down
    return x, s_new, buf


def setup_inputs(seed: int = 0) -> dict:
    key = jax.random.key(seed)
    ks = jax.random.split(key, 16)
    nrm = jax.random.normal
    f = jnp.float32
    return {
        "x_prompt": nrm(ks[0], (BATCH, SEQ, D_MODEL), f),
        "x_sample": nrm(ks[1], (DEC_BATCH, DEC_SEQ, D_MODEL), f),
        "state_gla": 0.5 * nrm(ks[2], (DEPTH, DEC_BATCH, N_HEADS_GLA, HEAD_K, HEAD_V), f),
        "state_pool": nrm(ks[3], (DEPTH, DEC_BATCH, POOL_BUF, POOL_WIDTH), f),
        "norm1_g": 1.0 + 0.02 * nrm(ks[4], (DEPTH, D_MODEL), f),
        "w_in": nrm(ks[5], (DEPTH, D_MODEL, IN_WIDTH), f) * D_MODEL ** -0.5,
        "w_gate": nrm(ks[6], (DEPTH, GATE_RANK, KEY_WIDTH), f) * GATE_RANK ** -0.5,
        "b_gate": 0.1 * nrm(ks[7], (DEPTH, KEY_WIDTH), f),
        "gla_norm_g": 1.0 + 0.02 * nrm(ks[8], (DEPTH, HEAD_V), f),
        "pool_w": nrm(ks[9], (DEPTH, N_POOL_GROUPS, POOL_GROUP, POOL_GROUP), f) * POOL_GROUP ** -0.5,
        "pool_scale": 1.0 + 0.02 * nrm(ks[10], (DEPTH, POOL_WIDTH), f),
        "w_out": nrm(ks[11], (DEPTH, D_MODEL, D_MODEL), f) * D_MODEL ** -0.5,
        "norm2_g": 1.0 + 0.02 * nrm(ks[12], (DEPTH, D_MODEL), f),
        "w_up": nrm(ks[13], (DEPTH, D_MODEL, D_FF), f) * D_MODEL ** -0.5,
        "w_down": nrm(ks[14], (DEPTH, D_FF, D_MODEL), f) * D_FF ** -0.5,
        "final_g": 1.0 + 0.02 * nrm(ks[15], (D_MODEL,), f),
    }


def reference(x_prompt, x_sample, state_gla, state_pool, norm1_g, w_in, w_gate, b_gate,
              gla_norm_g, pool_w, pool_scale, w_out, norm2_g, w_up, w_down, final_g):
    xp, xs = x_prompt, x_sample
    B = xp.shape[0]
    gla_p, pool_p, gla_s, pool_s = [], [], [], []
    for l in range(DEPTH):
        params = (norm1_g[l], w_in[l], w_gate[l], b_gate[l], gla_norm_g[l], pool_w[l],
                  pool_scale[l], w_out[l], norm2_g[l], w_up[l], w_down[l])
        s0 = jnp.zeros((B, N_HEADS_GLA, HEAD_K, HEAD_V), jnp.float32)
        pre0 = jnp.zeros((B, 0, POOL_WIDTH), xp.dtype)
        xp, sp, bp = layer(xp, s0, pre0, *params)
        xs, ss, bs = layer(xs, state_gla[l], state_pool[l], *params)
        gla_p.append(sp.astype(state_gla.dtype))
        pool_p.append(bp.astype(state_pool.dtype))
        gla_s.append(ss.astype(state_gla.dtype))
        pool_s.append(bs.astype(state_pool.dtype))
    y_prompt = rmsnorm(xp, final_g)
    y_sample = rmsnorm(xs, final_g)
    return (y_prompt, y_sample, jnp.stack(gla_p), jnp.stack(pool_p), jnp.stack(gla_s), jnp.stack(pool_s))
```

```cpp
#include <hip/hip_runtime.h>
#include <hip/hip_cooperative_groups.h>
#include <cstdio>
#include <cstdint>
namespace cg = cooperative_groups;

#define LAS __attribute__((address_space(3)))
typedef unsigned short bf16_t;
typedef short bf16x8 __attribute__((ext_vector_type(8)));
typedef float f32x4 __attribute__((ext_vector_type(4)));
typedef float f32x2 __attribute__((ext_vector_type(2)));
typedef __bf16 bf16x2n __attribute__((ext_vector_type(2)));
typedef unsigned u32x4 __attribute__((ext_vector_type(4)));
typedef unsigned u32x2 __attribute__((ext_vector_type(2)));

constexpr int D = 1024, SEQ = 2048, NBATCH = 8, MP = NBATCH * SEQ, MS = 128, MT = MP + MS, DEPTH = 4;
constexpr int FF = 4096, INW = 2064, ZLD = 2048;
constexpr float EPS = 1e-6f;
constexpr int ZQ = 0, ZK = 256, ZV = 512, ZG = 1024, ZU = 1536;
constexpr size_t O_GLAP = (size_t)MT * D, O_POOLP = O_GLAP + 4 * 8 * 4 * 64 * 128, O_GLAS = O_POOLP + 4 * 8 * 15 * 512, O_POOLS = O_GLAS + (size_t)4 * 128 * 4 * 64 * 128;
constexpr size_t MiB = 1u << 20;
constexpr size_t WS_ALOW = 1 * MiB, WS_DEC = 3 * MiB, WS_W = 4 * MiB, W_STRIDE = 23 * MiB;
constexpr size_t W_IN = 0, W_OUT = 4 * MiB + 512 * 1024, W_UP = W_OUT + 2 * MiB, W_DOWN = W_UP + 8 * MiB, W_POOL = W_DOWN + 8 * MiB;
constexpr size_t WS_XB = 96 * MiB, WS_Z = 129 * MiB, WS_MIX = 194 * MiB, WS_HID = 129 * MiB, WS_KVT = 227 * MiB, WS_ST = 259 * MiB, WS_RSP = 275 * MiB, WS_RSS = 284 * MiB, WS_QKV = 285 * MiB, WS_END = 317 * MiB;
static_assert(W_POOL + 128 * 1024 <= W_STRIDE && WS_W + 4 * W_STRIDE <= WS_XB, "weight map");
constexpr int LDS_BYTES = 147456, MISC_OFF = 131072 + 320;
constexpr size_t WS_CTL = 0, CTL_ZERO_BYTES = 16384;
constexpr int NPHASE = 2 + 7 * DEPTH;

__device__ __forceinline__ unsigned cvtpk(float lo, float hi) { f32x2 v = {lo, hi}; bf16x2n b = __builtin_convertvector(v, bf16x2n); return __builtin_bit_cast(unsigned, b); }
__device__ __forceinline__ bf16_t f2bf(float f) { return (bf16_t)(cvtpk(f, 0.f) & 0xffffu); }
__device__ __forceinline__ float bf2f(bf16_t h) { return __uint_as_float((unsigned)h << 16); }
__device__ __forceinline__ float bflo(unsigned w) { return __uint_as_float(w << 16); }
__device__ __forceinline__ float bfhi(unsigned w) { return __uint_as_float(w & 0xffff0000u); }
__device__ __forceinline__ float wave_sum(float v) {
#pragma unroll
    for (int o = 1; o < 64; o <<= 1) v += __shfl_xor(v, o);
    return v;
}
#define LDS_WAIT() asm volatile("s_waitcnt lgkmcnt(0)" ::: "memory")

namespace pg8 {
constexpr int BM = 256, BK = 64, HALF = 128, HTB = HALF * BK * 2, STAGE_BYTES = 8 * HTB, NXCD = 8, WGM = 8;
__host__ __device__ __forceinline__ int lds_byte(int r, int c) { const int st = (r >> 4) * 2 + (c >> 5), rr = r & 15, cc = c & 31, ob = rr * 64 + cc * 2; return st * 1024 + (ob ^ (((ob >> 9) & 1) << 5)); }
__host__ __device__ __forceinline__ void stage_rc(int b, int& R, int& C) { const int st = b / 1024, sb = b % 1024, swz = sb ^ (((sb >> 9) & 1) << 5); R = (st >> 1) * 16 + swz / 64; C = (st & 1) * 32 + (swz % 64) / 2; }
__host__ __device__ __forceinline__ int perm32(int rho) { const int n = rho >> 4, i = rho & 15; return 8 * (i >> 2) + 4 * n + (i & 3); }
struct Unit { int pm, pn; };
struct Gemm { const bf16_t* A; const bf16_t* Bt; int M, N, K; };
struct StaticOrder {
    int nM, nN, nwg, G, c;
    __host__ __device__ void init(int M, int N, int G_, int c_) { nM = M / BM; nN = N / BM; nwg = nM * nN; G = G_; c = c_; }
    __host__ __device__ bool next(int i, Unit& u) const {
        const long L = (long)i * G + c; if (L >= nwg) return false;
        int wgid = (int)L; { const int q = nwg / NXCD, r = nwg % NXCD, xcd = wgid % NXCD, off = wgid / NXCD; wgid = (xcd < r ? xcd * (q + 1) : r * (q + 1) + (xcd - r) * q) + off; }
        const int nig = WGM * nN, gid = wgid / nig, fm = gid * WGM, gsz = (nM - fm) < WGM ? (nM - fm) : WGM;
        u.pm = fm + ((wgid % nig) % gsz); u.pn = (wgid % nig) / gsz; return true;
    }
    __device__ __forceinline__ void a_ready(const Unit&) const {}
    __device__ __forceinline__ void done(const Unit&) const {}
};

template <int ACT> struct EpiScaleBf16 {
    static constexpr bool PERM = true, AFTER_DRAIN = false;
    bf16_t* O; int ldc; const float* rowss;
    __device__ __forceinline__ void operator()(const f32x4 (&acc)[2][2][4][2], const Unit& u, int wr, int wc, int fr, int fq) const {
        const int row0 = u.pm * BM + wr * 64 + fr; const int col0 = u.pn * BM + wc * 32 + 8 * fq;
#pragma unroll
        for (int ai = 0; ai < 2; ++ai)
#pragma unroll
            for (int m = 0; m < 4; ++m) {
                const int row = row0 + ai * HALF + m * 16;
                const f32x4 s0 = *(const f32x4*)(rowss + (size_t)row * 16 + fq * 4);
                float tot = (s0[0] + s0[1]) + (s0[2] + s0[3]); tot += __shfl_xor(tot, 16); tot += __shfl_xor(tot, 32);
                const float rs = rsqrtf(tot * (1.0f / D) + EPS);
                bf16_t* rowp = O + (size_t)row * ldc + col0;
#pragma unroll
                for (int bj = 0; bj < 2; ++bj) {
                    f32x4 v0 = acc[ai][bj][m][0] * rs, v1 = acc[ai][bj][m][1] * rs;
                    if (ACT == 1) {
#pragma unroll
                        for (int e = 0; e < 4; ++e) { const float a = fmaxf(v0[e], 0.f), b = fmaxf(v1[e], 0.f); v0[e] = a * a; v1[e] = b * b; }
                    }
                    u32x4 w; w.x = cvtpk(v0[0], v0[1]); w.y = cvtpk(v0[2], v0[3]); w.z = cvtpk(v1[0], v1[1]); w.w = cvtpk(v1[2], v1[3]);
                    *(u32x4*)(rowp + bj * HALF) = w;
                }
            }
    }
};
struct EpiRes {
    static constexpr bool PERM = true, AFTER_DRAIN = false;
    bf16_t* XB; float* ssout;
    __device__ __forceinline__ void operator()(const f32x4 (&acc)[2][2][4][2], const Unit& u, int wr, int wc, int fr, int fq) const {
        const int row0 = u.pm * BM + wr * 64 + fr; const int col0 = u.pn * BM + wc * 32 + 8 * fq;
#pragma unroll
        for (int ai = 0; ai < 2; ++ai)
#pragma unroll
            for (int m = 0; m < 4; ++m) {
                const int row = row0 + ai * HALF + m * 16;
                bf16_t* br = XB + (size_t)row * D + col0;
                float ss = 0.f;
#pragma unroll
                for (int bj = 0; bj < 2; ++bj) {
                    const u32x4 xo = *(const u32x4*)(br + bj * HALF);
                    const f32x4 a0 = acc[ai][bj][m][0], a1 = acc[ai][bj][m][1];
                    u32x4 w; w.x = cvtpk(bflo(xo.x) + a0[0], bfhi(xo.x) + a0[1]); w.y = cvtpk(bflo(xo.y) + a0[2], bfhi(xo.y) + a0[3]);
                    w.z = cvtpk(bflo(xo.z) + a1[0], bfhi(xo.z) + a1[1]); w.w = cvtpk(bflo(xo.w) + a1[2], bfhi(xo.w) + a1[3]);
                    *(u32x4*)(br + bj * HALF) = w;
#pragma unroll
                    for (int e = 0; e < 4; ++e) { const float lo = bflo(w[e]), hi = bfhi(w[e]); ss += lo * lo + hi * hi; }
                }
                ss += __shfl_xor(ss, 16); ss += __shfl_xor(ss, 32);
                if (fq == 0) ssout[(size_t)row * 16 + u.pn * 4 + wc] = ss;
            }
    }
};
struct EpiNull {
    static constexpr bool PERM = false, AFTER_DRAIN = false;
    float* sink; int flag;
    __device__ __forceinline__ void operator()(const f32x4 (&acc)[2][2][4][2], const Unit& u, int wr, int wc, int fr, int fq) const {
        if (flag) { f32x4 t = (f32x4){0.f, 0.f, 0.f, 0.f};
#pragma unroll
            for (int ai = 0; ai < 2; ++ai)
#pragma unroll
                for (int bj = 0; bj < 2; ++bj)
#pragma unroll
                    for (int m = 0; m < 4; ++m)
#pragma unroll
                        for (int n = 0; n < 2; ++n) t = t + acc[ai][bj][m][n];
            *(f32x4*)(sink + (size_t)(u.pm * 4 + u.pn) * 2048 + (wr * 4 + wc) * 256 + (fq * 16 + fr) * 4) = t; }
    }
};
template <class Epi, class Sched, bool ALIGN_EPI = false, bool SP2 = false>
__device__ __forceinline__ void gemm_phase(LAS unsigned char* lds, const Gemm g, const Sched& S, const Epi& E, const int tid) {
    const int wid = __builtin_amdgcn_readfirstlane(tid >> 6), lane = tid & 63, wr = wid >> 2, wc = wid & 3, fr = lane & 15, fq = lane >> 4;
    const int K = g.K, nt = K / BK;
    unsigned voffA[2], voffB[2];
#pragma unroll
    for (int i = 0; i < 2; ++i) { int R, C; stage_rc(tid * 16 + i * 8192, R, C); const int Rb = Epi::PERM ? ((R & ~31) + perm32(R & 31)) : R;
        voffA[i] = (unsigned)(R * K + C) * 2u; voffB[i] = (unsigned)(Rb * K + C) * 2u; }
    const size_t kstep = (size_t)(BK * 2);
    const size_t hstep = (size_t)HALF * K * 2;
    const size_t tstep = 2 * hstep;
    const unsigned ldsw = (unsigned)wid * 1024u;
    const int aoff = lds_byte(wr * 64 + fr, fq * 8), boff = lds_byte(wc * 32 + fr, fq * 8);
#define PG8_SA(b, h) (((b) * 2 + (h)) * HTB)
#define PG8_SB(b, h) ((4 + (b) * 2 + (h)) * HTB)
#define PG8_STAGE(bufoff, gbase, voff) do { _Pragma("unroll") for (int _i = 0; _i < 2; ++_i) \
        __builtin_amdgcn_global_load_lds((const unsigned*)((const char*)(gbase) + (voff)[_i]), (LAS unsigned*)(lds + (bufoff) + ldsw + _i * 8192), 16, 0, 0); } while (0)
#define PG8_LDA(dst, b, h) do { _Pragma("unroll") for (int m = 0; m < 4; ++m) _Pragma("unroll") for (int k = 0; k < 2; ++k) dst[m][k] = *(const LAS bf16x8*)(lds + PG8_SA(b, h) + aoff + m * 2048 + k * 1024); } while (0)
#define PG8_LDB(dst, b, h) do { _Pragma("unroll") for (int n = 0; n < 2; ++n) _Pragma("unroll") for (int k = 0; k < 2; ++k) dst[n][k] = *(const LAS bf16x8*)(lds + PG8_SB(b, h) + boff + n * 2048 + k * 1024); } while (0)
#define PG8_MMA(ai, bj, At, Bt) do { __builtin_amdgcn_s_setprio(1); _Pragma("unroll") for (int m = 0; m < 4; ++m) _Pragma("unroll") for (int n = 0; n < 2; ++n) _Pragma("unroll") for (int k = 0; k < 2; ++k) \
        acc[ai][bj][m][n] = __builtin_amdgcn_mfma_f32_16x16x32_bf16(Bt[n][k], At[m][k], acc[ai][bj][m][n], 0, 0, 0); __builtin_amdgcn_s_setprio(0); } while (0)
#define PG8_WAIT_V(n) asm volatile("s_waitcnt vmcnt(" #n ")" ::: "memory")
#define PG8_WAIT_L(n) asm volatile("s_waitcnt lgkmcnt(" #n ")" ::: "memory")
#define PG8_BAR __builtin_amdgcn_s_barrier()
#define PG8_SCHED __builtin_amdgcn_sched_barrier(0)
    Unit cur, nxt; int ui = 0;
    if (!S.next(0, cur)) return;
    f32x4 acc[2][2][4][2];
#pragma unroll
    for (int a = 0; a < 2; ++a)
#pragma unroll
        for (int b = 0; b < 2; ++b)
#pragma unroll
            for (int m = 0; m < 4; ++m)
#pragma unroll
                for (int n = 0; n < 2; ++n) acc[a][b][m][n] = (f32x4){0.f, 0.f, 0.f, 0.f};
    bf16x8 At[4][2], B0[2][2], B1[2][2];
    const char* cA = (const char*)g.A + (size_t)cur.pm * tstep; const char* cB = (const char*)g.Bt + (size_t)cur.pn * tstep;
    S.a_ready(cur);
    if constexpr (SP2) {
        PG8_STAGE(PG8_SB(0, 0), cB, voffB); PG8_STAGE(PG8_SB(0, 1), cB + hstep, voffB); PG8_STAGE(PG8_SA(0, 0), cA, voffA); PG8_STAGE(PG8_SA(0, 1), cA + hstep, voffA);
        if (wr == 1) PG8_BAR;
        PG8_WAIT_V(2); PG8_BAR;
        PG8_STAGE(PG8_SB(1, 0), cB + kstep, voffB); PG8_STAGE(PG8_SA(1, 0), cA + kstep, voffA); PG8_STAGE(PG8_SB(1, 1), cB + hstep + kstep, voffB);
        PG8_WAIT_V(6); PG8_BAR;
    } else {
        PG8_STAGE(PG8_SB(0, 0), cB, voffB); PG8_STAGE(PG8_SA(0, 0), cA, voffA); PG8_STAGE(PG8_SB(0, 1), cB + hstep, voffB); PG8_STAGE(PG8_SA(0, 1), cA + hstep, voffA);
        if (wr == 1) PG8_BAR;
        PG8_WAIT_V(4); PG8_BAR;
        PG8_STAGE(PG8_SB(1, 0), cB + kstep, voffB); PG8_STAGE(PG8_SA(1, 0), cA + kstep, voffA); PG8_STAGE(PG8_SB(1, 1), cB + hstep + kstep, voffB);
        PG8_WAIT_V(6); PG8_BAR;
    }
    for (;;) {
        const bool has_next = S.next(ui + 1, nxt);
        const char* nA = has_next ? (const char*)g.A + (size_t)nxt.pm * tstep : cA; const char* nB = has_next ? (const char*)g.Bt + (size_t)nxt.pn * tstep : cB;
        for (int t = 0; t < nt; t += 2) {
            const bool last = (t == nt - 2);
            const char* a1 = cA + (size_t)(t + 1) * kstep;
            const char* a2 = last ? nA : cA + (size_t)(t + 2) * kstep; const char* b2 = last ? nB : cB + (size_t)(t + 2) * kstep;
            const char* a3 = a2 + kstep; const char* b3 = b2 + kstep;
            if (last && has_next) S.a_ready(nxt);
            if constexpr (SP2) {
            PG8_LDB(B0, 0, 0); PG8_LDB(B1, 0, 1); PG8_SCHED; PG8_LDA(At, 0, 0); PG8_STAGE(PG8_SA(1, 1), a1 + hstep, voffA);
            PG8_WAIT_V(8); PG8_WAIT_L(0); PG8_BAR; PG8_MMA(0, 0, At, B0); PG8_MMA(0, 1, At, B1); PG8_BAR; PG8_SCHED;
            PG8_LDA(At, 0, 1); PG8_STAGE(PG8_SB(0, 0), b2, voffB); PG8_STAGE(PG8_SB(0, 1), b2 + hstep, voffB); PG8_STAGE(PG8_SA(0, 0), a2, voffA);
            PG8_WAIT_V(8); PG8_WAIT_L(0); PG8_BAR; PG8_MMA(1, 0, At, B0); PG8_MMA(1, 1, At, B1); PG8_BAR; PG8_SCHED;
            PG8_LDB(B0, 1, 0); PG8_LDB(B1, 1, 1); PG8_SCHED; PG8_LDA(At, 1, 0); PG8_STAGE(PG8_SA(0, 1), a2 + hstep, voffA);
            PG8_WAIT_V(8); PG8_WAIT_L(0); PG8_BAR; PG8_MMA(0, 0, At, B0); PG8_MMA(0, 1, At, B1); PG8_BAR; PG8_SCHED;
            PG8_LDA(At, 1, 1); PG8_STAGE(PG8_SB(1, 0), b3, voffB); PG8_STAGE(PG8_SB(1, 1), b3 + hstep, voffB); PG8_STAGE(PG8_SA(1, 0), a3, voffA);
            PG8_WAIT_V(8); PG8_WAIT_L(0); PG8_BAR; PG8_MMA(1, 0, At, B0); PG8_MMA(1, 1, At, B1); PG8_BAR; PG8_SCHED;
            } else {
            PG8_LDB(B0, 0, 0); PG8_SCHED; PG8_LDA(At, 0, 0); PG8_STAGE(PG8_SA(1, 1), a1 + hstep, voffA);
            PG8_WAIT_L(8); PG8_BAR; PG8_WAIT_L(0); PG8_MMA(0, 0, At, B0); PG8_BAR; PG8_SCHED;
            PG8_LDB(B1, 0, 1); PG8_STAGE(PG8_SB(0, 0), b2, voffB);
            PG8_BAR; PG8_WAIT_L(0); PG8_MMA(0, 1, At, B1); PG8_BAR;
            PG8_LDA(At, 0, 1); PG8_STAGE(PG8_SA(0, 0), a2, voffA);
            PG8_BAR; PG8_WAIT_L(0); PG8_MMA(1, 0, At, B0); PG8_BAR; PG8_SCHED;
            PG8_STAGE(PG8_SB(0, 1), b2 + hstep, voffB);
            PG8_WAIT_V(6); PG8_BAR; PG8_MMA(1, 1, At, B1); PG8_BAR;
            PG8_LDB(B0, 1, 0); PG8_SCHED; PG8_LDA(At, 1, 0); PG8_STAGE(PG8_SA(0, 1), a2 + hstep, voffA);
            PG8_WAIT_L(8); PG8_BAR; PG8_WAIT_L(0); PG8_MMA(0, 0, At, B0); PG8_BAR; PG8_SCHED;
            PG8_LDB(B1, 1, 1); PG8_STAGE(PG8_SB(1, 0), b3, voffB);
            PG8_BAR; PG8_WAIT_L(0); PG8_MMA(0, 1, At, B1); PG8_BAR;
            PG8_LDA(At, 1, 1); PG8_STAGE(PG8_SA(1, 0), a3, voffA);
            PG8_BAR; PG8_WAIT_L(0); PG8_MMA(1, 0, At, B0); PG8_BAR; PG8_SCHED;
            PG8_STAGE(PG8_SB(1, 1), b3 + hstep, voffB);
            PG8_WAIT_V(6); PG8_BAR; PG8_MMA(1, 1, At, B1); PG8_BAR;
            }
        }
        if constexpr (ALIGN_EPI) { if (wr == 0) PG8_BAR; }
        if constexpr (!Epi::AFTER_DRAIN) { E(acc, cur, wr, wc, fr, fq); S.done(cur); }
        if (!has_next) break;
#pragma unroll
        for (int a = 0; a < 2; ++a)
#pragma unroll
            for (int b = 0; b < 2; ++b)
#pragma unroll
                for (int m = 0; m < 4; ++m)
#pragma unroll
                    for (int n = 0; n < 2; ++n) acc[a][b][m][n] = (f32x4){0.f, 0.f, 0.f, 0.f};
        cur = nxt; cA = nA; cB = nB; ++ui;
        if constexpr (ALIGN_EPI) { if (wr == 1) PG8_BAR; }
    }
    PG8_WAIT_V(0);
    if constexpr (!ALIGN_EPI) { if (wr == 0) PG8_BAR; }
    PG8_BAR;
#undef PG8_SA
#undef PG8_SB
#undef PG8_STAGE
#undef PG8_LDA
#undef PG8_LDB
#undef PG8_MMA
#undef PG8_WAIT_V
#undef PG8_WAIT_L
#undef PG8_BAR
#undef PG8_SCHED
}
}

template <int MTN, int UNR, class Epi>
__device__ __forceinline__ void skinny_unit(LAS unsigned char* lds, const bf16_t* A, int lda, const bf16_t* Bt, int K, const Epi& E, const int tid) {
    const int wid = __builtin_amdgcn_readfirstlane(tid >> 6), lane = tid & 63, fr = lane & 15, fq = lane >> 4;
    const int kw = K / 8, k0 = wid * kw;
    f32x4 acc[MTN];
#pragma unroll
    for (int m = 0; m < MTN; ++m) acc[m] = (f32x4){0.f, 0.f, 0.f, 0.f};
    const bf16_t* ap = A + (size_t)fr * lda + k0 + fq * 8;
    const bf16_t* bp = Bt + (size_t)fr * K + k0 + fq * 8;
    for (int ks = 0; ks < kw; ks += 32 * UNR) {
        bf16x8 b[UNR], a[UNR][MTN];
#pragma unroll
        for (int u = 0; u < UNR; ++u) { b[u] = *(const bf16x8*)(bp + ks + u * 32);
#pragma unroll
            for (int m = 0; m < MTN; ++m) a[u][m] = *(const bf16x8*)(ap + (size_t)(m * 16) * lda + ks + u * 32); }
#pragma unroll
        for (int u = 0; u < UNR; ++u)
#pragma unroll
            for (int m = 0; m < MTN; ++m) acc[m] = __builtin_amdgcn_mfma_f32_16x16x32_bf16(a[u][m], b[u], acc[m], 0, 0, 0);
    }
    constexpr int ROWS = MTN * 16;
    LAS float* part = (LAS float*)lds;
#pragma unroll
    for (int m = 0; m < MTN; ++m)
#pragma unroll
        for (int j = 0; j < 4; ++j) part[(wid * ROWS + m * 16 + fq * 4 + j) * 16 + fr] = acc[m][j];
    __syncthreads();
    if (tid < ROWS * 4) {
        const int row = tid >> 2, c4 = (tid & 3) * 4;
        f32x4 s = (f32x4){0.f, 0.f, 0.f, 0.f};
#pragma unroll
        for (int w = 0; w < 8; ++w) s = s + *(const LAS f32x4*)(part + (w * ROWS + row) * 16 + c4);
        E(row, c4, s, tid);
    }
    __syncthreads();
}
template <int NS> __device__ __forceinline__ float sk_rstd(const float* base, int row, int tid) {
    const f32x4* p = (const f32x4*)(base + (size_t)row * NS + (tid & 3) * (NS / 4)); float s = 0.f;
#pragma unroll
    for (int i = 0; i < NS / 16; ++i) { const f32x4 v = p[i]; s += (v[0] + v[1]) + (v[2] + v[3]); }
    s += __shfl_xor(s, 1); s += __shfl_xor(s, 2);
    return rsqrtf(s * (1.0f / D) + EPS);
}
template <int NS> struct SkAlow { float* O; const float* rowss; __device__ __forceinline__ void operator()(int row, int c4, f32x4 v, int tid) const {
    const float rs = sk_rstd<NS>(rowss, row, tid); *(f32x4*)(O + (size_t)row * 16 + c4) = v * rs; } };
template <int ACT> struct SkScaleBf16 { bf16_t* O; int ldc; const float* rowss; __device__ __forceinline__ void operator()(int row, int c4, f32x4 v, int tid) const {
    const float rs = sk_rstd<64>(rowss, row, tid); v = v * rs;
    if (ACT == 1) {
#pragma unroll
        for (int e = 0; e < 4; ++e) { const float a = fmaxf(v[e], 0.f); v[e] = a * a; } }
    u32x2 w; w.x = cvtpk(v[0], v[1]); w.y = cvtpk(v[2], v[3]); *(u32x2*)(O + (size_t)row * ldc + c4) = w; } };
struct SkRes { bf16_t* XB; float* ssout; int slot; __device__ __forceinline__ void operator()(int row, int c4, f32x4 v, int tid) const {
    const u32x2 xo = *(const u32x2*)(XB + (size_t)row * D + c4);
    u32x2 w; w.x = cvtpk(bflo(xo.x) + v[0], bfhi(xo.x) + v[1]); w.y = cvtpk(bflo(xo.y) + v[2], bfhi(xo.y) + v[3]); *(u32x2*)(XB + (size_t)row * D + c4) = w;
    float ss = (bflo(w.x) * bflo(w.x) + bfhi(w.x) * bfhi(w.x)) + (bflo(w.y) * bflo(w.y) + bfhi(w.y) * bfhi(w.y)); ss += __shfl_xor(ss, 1); ss += __shfl_xor(ss, 2);
    if ((tid & 3) == 0) ssout[(size_t)row * 64 + slot] = ss; } };

#define XB_TMO      128
#define XB_XCNT(j)  (256  + 64 * (j))
#define XB_XSUB(j)  (1280 + 64 * (j))
#define XB_XGEN(j)  (2304 + 64 * (j))
#define XB_TOP      3328
#define XB_TOPGEN   3392
#define XCD_BAR_WORDS 3456
#define XB_SPIN_CAP (1u << 18)
__device__ __forceinline__ unsigned xb_ld(unsigned* p)              { return __hip_atomic_load(p, __ATOMIC_RELAXED, __HIP_MEMORY_SCOPE_AGENT); }
__device__ __forceinline__ unsigned xb_add(unsigned* p, unsigned v) { return __hip_atomic_fetch_add(p, v, __ATOMIC_RELAXED, __HIP_MEMORY_SCOPE_AGENT); }
__device__ __forceinline__ unsigned xb_xcc_id() { return (unsigned)__builtin_amdgcn_s_getreg((3 << 11) | 20) & 0xFu; }
#define XB_SPIN(cond, bar) do { unsigned _sp = 0; while (cond) { __builtin_amdgcn_s_sleep(1); \
    if ((++_sp & 255u) == 0u) { if (xb_ld(&(bar)[XB_TMO])) break; if (_sp > XB_SPIN_CAP) { atomicAdd(&(bar)[XB_TMO], 1u); break; } } } } while (0)
struct XcdBarrier { unsigned* bar; unsigned x; volatile LAS unsigned* st; };
__device__ __forceinline__ XcdBarrier xcd_barrier_post(unsigned* bar, volatile LAS unsigned* st) {
    XcdBarrier b; b.bar = bar; b.x = xb_xcc_id(); b.st = st;
    if (threadIdx.x == 0) (void)xb_add(&bar[XB_XCNT(b.x)], 1u);
    return b;
}
__device__ __forceinline__ void xcd_barrier_complete(unsigned* bar, unsigned x, unsigned& nloc, unsigned& nx) {
    const unsigned G = gridDim.x * gridDim.y * gridDim.z;
    unsigned sum, cnt, mine, sp = 0u;
    for (;;) {
        sum = 0u; cnt = 0u; mine = 0u;
#pragma unroll
        for (unsigned j = 0; j < 16; ++j) { const unsigned c = xb_ld(&bar[XB_XCNT(j)]); sum += c; cnt += (c > 0u) ? 1u : 0u; mine = (j == x) ? c : mine; }
        if (sum == G) break;
        __builtin_amdgcn_s_sleep(1);
        if ((++sp & 255u) == 0u) { if (xb_ld(&bar[XB_TMO])) break; if (sp > XB_SPIN_CAP) { atomicAdd(&bar[XB_TMO], 1u); break; } }
    }
    nloc = mine > 0u ? mine : 1u; nx = cnt > 0u ? cnt : 1u;
}
__device__ __forceinline__ void xcd_barrier(const XcdBarrier& b) {
    asm volatile("s_waitcnt vmcnt(0)" ::: "memory");
    __syncthreads();
    if (threadIdx.x == 0) {
        unsigned* bar = b.bar;
        __builtin_amdgcn_s_waitcnt(0);
        unsigned nloc = b.st[0], nx = b.st[1];
        if (nloc == 0u) { xcd_barrier_complete(bar, b.x, nloc, nx); b.st[0] = nloc; b.st[1] = nx; }
        const unsigned old = xb_add(&bar[XB_XSUB(b.x)], 1u);
        const unsigned gen = old / nloc;
        if (old + 1u == (gen + 1u) * nloc) {
            __builtin_amdgcn_fence(__ATOMIC_RELEASE, "agent");
            asm volatile("s_waitcnt vmcnt(0)" ::: "memory");
            const unsigned og = xb_add(&bar[XB_TOP], 1u);
            const unsigned tg = og / nx;
            if (og + 1u == (tg + 1u) * nx) xb_add(&bar[XB_TOPGEN], 1u);
            else XB_SPIN(xb_ld(&bar[XB_TOPGEN]) == tg, bar);
            __builtin_amdgcn_fence(__ATOMIC_ACQUIRE, "");
            xb_add(&bar[XB_XGEN(b.x)], 1u);
            asm volatile("s_waitcnt vmcnt(0)" ::: "memory");
        } else {
            XB_SPIN(xb_ld(&bar[XB_XGEN(b.x)]) == gen, bar);
            __builtin_amdgcn_fence(__ATOMIC_ACQUIRE, "");
            asm volatile("s_waitcnt vmcnt(0)" ::: "memory");
        }
    }
    __syncthreads();
}

struct Args { const float* in[16]; float* out; unsigned char* ws; int ph_lo, ph_hi, coop, pad; };
struct Frame {
    LAS unsigned char* lds; int tid, lane, wave, G, bid;
    const float *x_prompt, *x_sample, *state_gla, *state_pool, *norm1_g, *w_in, *w_gate, *b_gate, *gla_norm_g, *pool_w, *pool_scale, *w_out, *norm2_g, *w_up, *w_down, *final_g;
    float* out; unsigned char* ws;
    float *rsp, *rss, *alow, *dec, *kvt; bf16_t *xb, *z, *mix, *hid, *st, *qt, *kt, *vt;
};
__device__ __forceinline__ bf16_t* wptr(const Frame& F, int l, size_t off) { return (bf16_t*)(F.ws + WS_W + (size_t)l * W_STRIDE + off); }

struct TItem { const float* W; bf16_t* WT; const float* kscale; int ldw, K, k0, nsrc0, ndst0, nvalid; };
struct TRegs { f32x4 v[8]; float ks[8]; };
__device__ __forceinline__ void titem_decode(const Frame& F, int it, TItem& T) {
    constexpr int I_IN = 16 * 65, I_OUT = 16 * 32, I_UP = 16 * 128, I_DOWN = 64 * 32, I_POOL = 32, I_LAYER = I_IN + I_OUT + I_UP + I_DOWN + I_POOL;
    const int l = it / I_LAYER; int r = it % I_LAYER;
    if (r < I_IN) { const int kb = r / 65, nb = r % 65, nd = nb * 32;
        T = TItem{F.w_in + (size_t)l * D * INW, wptr(F, l, W_IN), F.norm1_g + l * D, INW, D, kb * 64, nd < 1536 ? nd : (nd < 2048 ? nd + 16 : 1536), nd, nd < 2048 ? 32 : 16}; return; } r -= I_IN;
    if (r < I_OUT) { const int kb = r / 32, nb = r % 32; T = TItem{F.w_out + (size_t)l * D * D, wptr(F, l, W_OUT), nullptr, D, D, kb * 64, nb * 32, nb * 32, 32}; return; } r -= I_OUT;
    if (r < I_UP) { const int kb = r / 128, nb = r % 128; T = TItem{F.w_up + (size_t)l * D * FF, wptr(F, l, W_UP), F.norm2_g + l * D, FF, D, kb * 64, nb * 32, nb * 32, 32}; return; } r -= I_UP;
    if (r < I_DOWN) { const int kb = r / 32, nb = r % 32; T = TItem{F.w_down + (size_t)l * FF * D, wptr(F, l, W_DOWN), nullptr, D, FF, kb * 64, nb * 32, nb * 32, 32}; return; } r -= I_DOWN;
    { const int g = r / 8, kb = (r % 8) / 4, nb = r % 4; T = TItem{F.pool_w + ((size_t)l * 4 + g) * 128 * 128, wptr(F, l, W_POOL) + g * 16384, nullptr, 128, 128, kb * 64, nb * 32, nb * 32, 32}; }
}
__device__ __forceinline__ void titem_load(const TItem& T, TRegs& R, int lane) {
    const int c4 = (lane & 7) * 4, kr = lane >> 3;
#pragma unroll
    for (int i = 0; i < 8; ++i) { const int kk = 8 * i + kr; R.v[i] = (c4 < T.nvalid) ? *(const f32x4*)(T.W + (size_t)(T.k0 + kk) * T.ldw + T.nsrc0 + c4) : (f32x4){0.f, 0.f, 0.f, 0.f}; R.ks[i] = T.kscale ? T.kscale[T.k0 + kk] : 1.0f; }
}
__device__ __forceinline__ void titem_store(const TItem& T, const TRegs& R, LAS float* scr, int lane) {
    const int c4 = (lane & 7) * 4, kr = lane >> 3;
#pragma unroll
    for (int i = 0; i < 8; ++i) { const int kk = 8 * i + kr;
#pragma unroll
        for (int e = 0; e < 4; ++e) scr[kk * 33 + c4 + e] = R.v[i][e] * R.ks[i]; }
    LDS_WAIT(); asm volatile("" ::: "memory");
    const int c8 = lane & 7;
#pragma unroll
    for (int j = 0; j < 4; ++j) { const int n = (lane >> 3) + 8 * j; const LAS float* s = scr + (8 * c8) * 33 + n;
        u32x4 o; o.x = cvtpk(s[0 * 33], s[1 * 33]); o.y = cvtpk(s[2 * 33], s[3 * 33]); o.z = cvtpk(s[4 * 33], s[5 * 33]); o.w = cvtpk(s[6 * 33], s[7 * 33]);
        if (n < T.nvalid) *(u32x4*)(T.WT + (size_t)(T.ndst0 + n) * T.K + T.k0 + 8 * c8) = o; }
    LDS_WAIT(); asm volatile("" ::: "memory");
}
__device__ __forceinline__ void p0_prologue(Frame& F) {
    LAS float* scr = (LAS float*)(F.lds + F.wave * 8704);
    const int gw = F.bid * 8 + F.wave, NGW = F.G * 8;
    constexpr int NITEMS = DEPTH * (16 * 65 + 16 * 32 + 16 * 128 + 64 * 32 + 32);
    {
        TItem T0, T1; TRegs R0, R1;
        if (gw < NITEMS) { titem_decode(F, gw, T0); titem_load(T0, R0, F.lane); }
        for (int it = gw; it < NITEMS; it += NGW) {
            const bool more = it + NGW < NITEMS;
            if (more) { titem_decode(F, it + NGW, T1); titem_load(T1, R1, F.lane); }
            titem_store(T0, R0, scr, F.lane);
            if (more) { T0 = T1; R0 = R1; }
        }
    }
    f32x4 v0[4], v1[4];
    if (gw < MT) { const float* src = gw < MP ? F.x_prompt + (size_t)gw * D : F.x_sample + (size_t)(gw - MP) * D;
#pragma unroll
        for (int j = 0; j < 4; ++j) v0[j] = ((const f32x4*)src + F.lane)[64 * j]; }
    for (int m = gw; m < MT; m += NGW) {
        const int mn = m + NGW;
        if (mn < MT) { const float* src = mn < MP ? F.x_prompt + (size_t)mn * D : F.x_sample + (size_t)(mn - MP) * D;
#pragma unroll
            for (int j = 0; j < 4; ++j) v1[j] = ((const f32x4*)src + F.lane)[64 * j]; }
        u32x2* bo = (u32x2*)(F.xb + (size_t)m * D) + F.lane;
        float s = 0.f;
#pragma unroll
        for (int j = 0; j < 4; ++j) { const f32x4 v = v0[j]; u32x2 w; w.x = cvtpk(v[0], v[1]); w.y = cvtpk(v[2], v[3]); bo[64 * j] = w; s += (v[0] * v[0] + v[1] * v[1]) + (v[2] * v[2] + v[3] * v[3]); }
        s = wave_sum(s);
        if (m < MP) { if (F.lane < 16) F.rsp[(size_t)m * 16 + F.lane] = F.lane == 0 ? s : 0.f; }
        else F.rss[(size_t)(m - MP) * 64 + F.lane] = F.lane == 0 ? s : 0.f;
        if (mn < MT) {
#pragma unroll
            for (int j = 0; j < 4; ++j) v0[j] = v1[j]; }
    }
}

constexpr int L_AL = 0, L_B = 4096, L_TOT = 20736, L_BL = 22784, L_QT = 23040, L_KT = 32256, L_VT = 41472, L_ATT = 59904, L_SS = 69120;
__device__ __forceinline__ float logsig(float x) { return fminf(x, 0.f) - __logf(1.f + __expf(-fabsf(x))); }
__device__ __forceinline__ float rdlane(float v, int lane) { return __int_as_float(__builtin_amdgcn_readlane(__float_as_int(v), lane)); }
struct KvC { float w[16]; float bj; };
struct KvU { f32x4 alv; bf16_t qv[8], kv[8]; u32x4 vv[2]; };
__device__ __forceinline__ void gla_kv_loadc(const Frame& F, int l, int h, KvC& C) {
    const int j = F.tid & 63; const float* wg = F.w_gate + (size_t)l * 16 * 256 + h * 64 + j;
#pragma unroll
    for (int r = 0; r < 16; ++r) C.w[r] = wg[r * 256];
    C.bj = F.b_gate[l * 256 + h * 64 + j];
}
__device__ __forceinline__ void gla_kv_load(const Frame& F, int unit, KvU& U) {
    const int bh = unit >> 5, n = unit & 31, b = bh >> 2, h = bh & 3, row0 = b * SEQ + n * 64, tid = F.tid, j = tid & 63, cgp = F.wave;
    const bf16_t* zrow0 = F.z + (size_t)row0 * ZLD;
    const float* al = F.alow + (size_t)(row0 + cgp * 8) * 16;
    U.alv = (f32x4){0.f, 0.f, 0.f, 0.f}; if (F.lane < 32) U.alv = *(const f32x4*)(al + F.lane * 4);
#pragma unroll
    for (int i = 0; i < 8; ++i) { const bf16_t* zr = zrow0 + (size_t)(cgp * 8 + i) * ZLD + h * 64 + j; U.qv[i] = zr[ZQ]; U.kv[i] = zr[ZK]; }
#pragma unroll
    for (int pass = 0; pass < 2; ++pass) U.vv[pass] = *(const u32x4*)(zrow0 + (size_t)((tid >> 4) + pass * 32) * ZLD + ZV + h * 128 + (tid & 15) * 8);
}
__device__ __forceinline__ void gla_kv_unit(const Frame& F, int l, int unit, const KvC& C, const KvU& U) {
    const int tid = F.tid;
    LAS float* sTot = (LAS float*)(F.lds + L_TOT);
    LAS bf16_t* sQt = (LAS bf16_t*)(F.lds + L_QT); LAS bf16_t* sKt = (LAS bf16_t*)(F.lds + L_KT); LAS bf16_t* sKeT = (LAS bf16_t*)(F.lds + L_ATT); LAS bf16_t* sVT = (LAS bf16_t*)(F.lds + L_VT);
    const int j = tid & 63, cgp = F.wave;
    const f32x4 alv = U.alv; const float bj = C.bj;
    float loc[8]; float run = 0.f;
#pragma unroll
    for (int i = 0; i < 8; ++i) { float ga = bj;
#pragma unroll
        for (int r = 0; r < 16; ++r) ga += rdlane(alv[r & 3], i * 4 + (r >> 2)) * C.w[r];
        run += logsig(ga) * (1.0f / 16.0f); loc[i] = run; }
    sTot[cgp * 64 + j] = run;
#pragma unroll
    for (int pass = 0; pass < 2; ++pass) { const int vg = tid & 15, sidx = (tid >> 4) + pass * 32;
#pragma unroll
        for (int i = 0; i < 4; ++i) { sVT[(vg * 8 + 2 * i) * 72 + sidx] = (bf16_t)(U.vv[pass][i] & 0xffffu); sVT[(vg * 8 + 2 * i + 1) * 72 + sidx] = (bf16_t)(U.vv[pass][i] >> 16); } }
    __syncthreads();
    float off = 0.f, tot = 0.f;
#pragma unroll
    for (int g = 0; g < 8; ++g) { const float tv = sTot[g * 64 + j]; off += (g < cgp) ? tv : 0.f; tot += tv; }
    u32x4 kep;
#pragma unroll
    for (int i = 0; i < 8; i += 2) {
        const float b0 = off + loc[i], b1 = off + loc[i + 1];
        const float q0 = bf2f(U.qv[i]), q1 = bf2f(U.qv[i + 1]), k0 = bf2f(U.kv[i]), k1 = bf2f(U.kv[i + 1]);
        sQt[(cgp * 8 + i) * 72 + j] = f2bf(q0 * __expf(b0) * 0.125f); sQt[(cgp * 8 + i + 1) * 72 + j] = f2bf(q1 * __expf(b1) * 0.125f);
        sKt[(cgp * 8 + i) * 72 + j] = f2bf(k0 * __expf(-b0)); sKt[(cgp * 8 + i + 1) * 72 + j] = f2bf(k1 * __expf(-b1));
        kep[i >> 1] = cvtpk(k0 * __expf(tot - b0), k1 * __expf(tot - b1)); }
    *(LAS u32x4*)(sKeT + j * 72 + cgp * 8) = kep;
    if (cgp == 0) F.dec[unit * 64 + j] = __expf(tot);
    __syncthreads();
    const int wv = F.wave, fr = F.lane & 15, fq = F.lane >> 4;
    f32x4 acc[4];
#pragma unroll
    for (int nt = 0; nt < 4; ++nt) acc[nt] = (f32x4){0.f, 0.f, 0.f, 0.f};
#pragma unroll
    for (int ks = 0; ks < 2; ++ks) { const bf16x8 a = *(const LAS bf16x8*)(sVT + (wv * 16 + fr) * 72 + ks * 32 + fq * 8);
#pragma unroll
        for (int nt = 0; nt < 4; ++nt) { const bf16x8 bb = *(const LAS bf16x8*)(sKeT + (nt * 16 + fr) * 72 + ks * 32 + fq * 8); acc[nt] = __builtin_amdgcn_mfma_f32_16x16x32_bf16(a, bb, acc[nt], 0, 0, 0); } }
    { const int sr = tid >> 3, kg = tid & 7;
      *(u32x4*)(F.qt + (size_t)unit * 4096 + sr * 64 + kg * 8) = *(const LAS u32x4*)(sQt + sr * 72 + kg * 8);
      *(u32x4*)(F.kt + (size_t)unit * 4096 + sr * 64 + kg * 8) = *(const LAS u32x4*)(sKt + sr * 72 + kg * 8);
#pragma unroll
      for (int p = 0; p < 2; ++p) { const int id = tid + 512 * p, vc = id >> 3, ch = id & 7; *(u32x4*)(F.vt + (size_t)unit * 8192 + vc * 64 + ch * 8) = *(const LAS u32x4*)(sVT + vc * 72 + ch * 8); } }
    float* kvt = F.kvt + (size_t)unit * 8192;
#pragma unroll
    for (int nt = 0; nt < 4; ++nt)
#pragma unroll
        for (int jj = 0; jj < 4; ++jj) kvt[(wv * 16 + fq * 4 + jj) * 64 + nt * 16 + fr] = acc[nt][jj];
    __syncthreads();
}
__device__ __forceinline__ void gla_gate_cumsum(const Frame& F, const float* alow_rows, const float* wg, const float* bg) {
    LAS float* sAl = (LAS float*)(F.lds + L_AL); LAS float* sB = (LAS float*)(F.lds + L_B); LAS float* sTot = (LAS float*)(F.lds + L_TOT); LAS float* sBl = (LAS float*)(F.lds + L_BL);
    const int tid = F.tid;
    if (tid < 256) *(LAS f32x4*)(sAl + tid * 4) = *(const f32x4*)(alow_rows + tid * 4);
    const int j = tid & 63, cgp = tid >> 6;
    float w[16];
#pragma unroll
    for (int r = 0; r < 16; ++r) w[r] = wg[r * 256 + j];
    const float bj = bg[j];
    __syncthreads();
    float loc[8]; float run = 0.f;
#pragma unroll
    for (int i = 0; i < 8; ++i) { const int c = cgp * 8 + i; float ga = bj;
#pragma unroll
        for (int r = 0; r < 16; ++r) ga += sAl[c * 16 + r] * w[r];
        run += logsig(ga) * (1.0f / 16.0f); loc[i] = run; }
    sTot[cgp * 64 + j] = run;
    __syncthreads();
    float off = 0.f, tot = 0.f;
#pragma unroll
    for (int g = 0; g < 8; ++g) { const float tv = sTot[g * 64 + j]; off += (g < cgp) ? tv : 0.f; tot += tv; }
#pragma unroll
    for (int i = 0; i < 8; ++i) sB[(cgp * 8 + i) * 65 + j] = off + loc[i];
    if (cgp == 0) sBl[j] = tot;
    __syncthreads();
}
__device__ __forceinline__ void load_vT(const Frame& F, const bf16_t* zrow0, int h) {
    LAS bf16_t* sVT = (LAS bf16_t*)(F.lds + L_VT);
#pragma unroll
    for (int pass = 0; pass < 2; ++pass) { const int vg = F.tid & 15, s = (F.tid >> 4) + pass * 32;
        const u32x4 vv = *(const u32x4*)(zrow0 + (size_t)s * ZLD + ZV + h * 128 + vg * 8);
#pragma unroll
        for (int i = 0; i < 4; ++i) { sVT[(vg * 8 + 2 * i) * 72 + s] = (bf16_t)(vv[i] & 0xffffu); sVT[(vg * 8 + 2 * i + 1) * 72 + s] = (bf16_t)(vv[i] >> 16); } }
}
__device__ __forceinline__ void gla_out_unit_old(const Frame& F, int l, int unit) {
    const int bh = unit >> 5, n = unit & 31, b = bh >> 2, h = bh & 3, row0 = b * SEQ + n * 64;
    const bf16_t* zrow0 = F.z + (size_t)row0 * ZLD;
    gla_gate_cumsum(F, F.alow + (size_t)row0 * 16, F.w_gate + (size_t)l * 16 * 256 + h * 64, F.b_gate + l * 256 + h * 64);
    LAS float* sB = (LAS float*)(F.lds + L_B); LAS float* sSS = (LAS float*)(F.lds + L_SS);
    LAS bf16_t* sQt = (LAS bf16_t*)(F.lds + L_QT); LAS bf16_t* sKt = (LAS bf16_t*)(F.lds + L_KT); LAS bf16_t* sVT = (LAS bf16_t*)(F.lds + L_VT); LAS bf16_t* sAtt = (LAS bf16_t*)(F.lds + L_ATT);
    { const int kg = F.tid & 7, s = F.tid >> 3;
      const u32x4 qv = *(const u32x4*)(zrow0 + (size_t)s * ZLD + ZQ + h * 64 + kg * 8);
      const u32x4 kv = *(const u32x4*)(zrow0 + (size_t)s * ZLD + ZK + h * 64 + kg * 8);
      u32x4 qo, ko;
#pragma unroll
      for (int i = 0; i < 4; ++i) { const int k0 = kg * 8 + 2 * i; const float b0 = sB[s * 65 + k0], b1 = sB[s * 65 + k0 + 1];
          qo[i] = cvtpk(bflo(qv[i]) * __expf(b0) * 0.125f, bfhi(qv[i]) * __expf(b1) * 0.125f);
          ko[i] = cvtpk(bflo(kv[i]) * __expf(-b0), bfhi(kv[i]) * __expf(-b1)); }
      *(LAS u32x4*)(sQt + s * 72 + kg * 8) = qo; *(LAS u32x4*)(sKt + s * 72 + kg * 8) = ko; }
    load_vT(F, zrow0, h);
    __syncthreads();
    const int w = F.wave, fr = F.lane & 15, fq = F.lane >> 4, mt = w >> 1;
#pragma unroll
    for (int q = 0; q < 2; ++q) { const int nt = (w & 1) * 2 + q;
        f32x4 acc = (f32x4){0.f, 0.f, 0.f, 0.f};
        if (nt <= mt) {
#pragma unroll
            for (int ks = 0; ks < 2; ++ks) { const bf16x8 a = *(const LAS bf16x8*)(sQt + (mt * 16 + fr) * 72 + ks * 32 + fq * 8); const bf16x8 bb = *(const LAS bf16x8*)(sKt + (nt * 16 + fr) * 72 + ks * 32 + fq * 8);
                acc = __builtin_amdgcn_mfma_f32_16x16x32_bf16(a, bb, acc, 0, 0, 0); } }
#pragma unroll
        for (int j = 0; j < 4; ++j) { const int c = mt * 16 + fq * 4 + j, s = nt * 16 + fr; sAtt[c * 72 + s] = f2bf(s <= c ? acc[j] : 0.f); } }
    __syncthreads();
    const int nt4 = (w & 1) * 4;
    f32x4 o[4];
#pragma unroll
    for (int q = 0; q < 4; ++q) o[q] = (f32x4){0.f, 0.f, 0.f, 0.f};
    const bf16_t* stg = F.st + (size_t)unit * 8192;
#pragma unroll
    for (int ks = 0; ks < 2; ++ks) {
        const bf16x8 a1 = *(const LAS bf16x8*)(sAtt + (mt * 16 + fr) * 72 + ks * 32 + fq * 8); const bf16x8 a2 = *(const LAS bf16x8*)(sQt + (mt * 16 + fr) * 72 + ks * 32 + fq * 8);
#pragma unroll
        for (int q = 0; q < 4; ++q) { const int nt = nt4 + q;
            const bf16x8 bv = *(const LAS bf16x8*)(sVT + (nt * 16 + fr) * 72 + ks * 32 + fq * 8); const bf16x8 bs = *(const bf16x8*)(stg + (nt * 16 + fr) * 64 + ks * 32 + fq * 8);
            o[q] = __builtin_amdgcn_mfma_f32_16x16x32_bf16(a1, bv, o[q], 0, 0, 0); o[q] = __builtin_amdgcn_mfma_f32_16x16x32_bf16(a2, bs, o[q], 0, 0, 0); } }
    float p[4];
#pragma unroll
    for (int j = 0; j < 4; ++j) { float s = 0.f;
#pragma unroll
        for (int q = 0; q < 4; ++q) s += o[q][j] * o[q][j];
        s += __shfl_xor(s, 1); s += __shfl_xor(s, 2); s += __shfl_xor(s, 4); s += __shfl_xor(s, 8); p[j] = s; }
    if (fr == 0) {
#pragma unroll
        for (int j = 0; j < 4; ++j) sSS[(w & 1) * 64 + mt * 16 + fq * 4 + j] = p[j]; }
    __syncthreads();
    const float* gn = F.gla_norm_g + l * 128;
#pragma unroll
    for (int j = 0; j < 4; ++j) { const int c = mt * 16 + fq * 4 + j; const float rs = rsqrtf((sSS[c] + sSS[64 + c]) * (1.0f / 128.0f) + EPS);
#pragma unroll
        for (int q = 0; q < 4; ++q) { const int vcol = (nt4 + q) * 16 + fr; const float gz = bf2f(zrow0[(size_t)c * ZLD + ZG + h * 128 + vcol]);
            const float val = o[q][j] * rs * gn[vcol] * (gz / (1.f + __expf(-gz)));
            F.mix[(size_t)(row0 + c) * D + h * 128 + vcol] = f2bf(val); } }
    __syncthreads();
}
struct OutU { u32x4 q16, k16, v16[2]; bf16x8 bs[4][2]; bf16_t gzr[4][4]; };
__device__ __forceinline__ void gla_out_load(const Frame& F, int unit, OutU& U) {
    const int bh = unit >> 5, n = unit & 31, b = bh >> 2, h = bh & 3, row0 = b * SEQ + n * 64;
    const bf16_t* zrow0 = F.z + (size_t)row0 * ZLD;
    const int w = F.wave, fr = F.lane & 15, fq = F.lane >> 4, mt = w >> 1, nt4 = (w & 1) * 4, sr = F.tid >> 3, kg = F.tid & 7;
    U.q16 = *(const u32x4*)(F.qt + (size_t)unit * 4096 + sr * 64 + kg * 8); U.k16 = *(const u32x4*)(F.kt + (size_t)unit * 4096 + sr * 64 + kg * 8);
#pragma unroll
    for (int p = 0; p < 2; ++p) { const int id = F.tid + 512 * p; U.v16[p] = *(const u32x4*)(F.vt + (size_t)unit * 8192 + (id >> 3) * 64 + (id & 7) * 8); }
    const bf16_t* stg = F.st + (size_t)unit * 8192;
#pragma unroll
    for (int q = 0; q < 4; ++q)
#pragma unroll
        for (int ks = 0; ks < 2; ++ks) U.bs[q][ks] = *(const bf16x8*)(stg + ((nt4 + q) * 16 + fr) * 64 + ks * 32 + fq * 8);
#pragma unroll
    for (int j = 0; j < 4; ++j)
#pragma unroll
        for (int q = 0; q < 4; ++q) U.gzr[j][q] = zrow0[(size_t)(mt * 16 + fq * 4 + j) * ZLD + ZG + h * 128 + (nt4 + q) * 16 + fr];
}
__device__ __forceinline__ void gla_out_unit_v3(const Frame& F, int l, int unit, const OutU& U, const float (&gnv)[4]) {
    const int bh = unit >> 5, n = unit & 31, b = bh >> 2, h = bh & 3, row0 = b * SEQ + n * 64;
    LAS float* sSS = (LAS float*)(F.lds + L_SS);
    LAS bf16_t* sQt = (LAS bf16_t*)(F.lds + L_QT); LAS bf16_t* sKt = (LAS bf16_t*)(F.lds + L_KT); LAS bf16_t* sVT = (LAS bf16_t*)(F.lds + L_VT); LAS bf16_t* sAtt = (LAS bf16_t*)(F.lds + L_ATT);
    const int w = F.wave, fr = F.lane & 15, fq = F.lane >> 4, mt = w >> 1, nt4 = (w & 1) * 4;
    { const int sr = F.tid >> 3, kg = F.tid & 7;
      *(LAS u32x4*)(sQt + sr * 72 + kg * 8) = U.q16; *(LAS u32x4*)(sKt + sr * 72 + kg * 8) = U.k16;
#pragma unroll
      for (int p = 0; p < 2; ++p) { const int id = F.tid + 512 * p; *(LAS u32x4*)(sVT + (id >> 3) * 72 + (id & 7) * 8) = U.v16[p]; } }
    __syncthreads();
#pragma unroll
    for (int q = 0; q < 2; ++q) { const int nt = (w & 1) * 2 + q;
        f32x4 acc = (f32x4){0.f, 0.f, 0.f, 0.f};
        if (nt <= mt) {
#pragma unroll
            for (int ks = 0; ks < 2; ++ks) { const bf16x8 a = *(const LAS bf16x8*)(sQt + (mt * 16 + fr) * 72 + ks * 32 + fq * 8); const bf16x8 bb = *(const LAS bf16x8*)(sKt + (nt * 16 + fr) * 72 + ks * 32 + fq * 8);
                acc = __builtin_amdgcn_mfma_f32_16x16x32_bf16(a, bb, acc, 0, 0, 0); } }
#pragma unroll
        for (int j = 0; j < 4; ++j) { const int c = mt * 16 + fq * 4 + j, s = nt * 16 + fr; sAtt[c * 72 + s] = f2bf(s <= c ? acc[j] : 0.f); } }
    __syncthreads();
    f32x4 o[4];
#pragma unroll
    for (int q = 0; q < 4; ++q) o[q] = (f32x4){0.f, 0.f, 0.f, 0.f};
#pragma unroll
    for (int ks = 0; ks < 2; ++ks) {
        const bf16x8 a1 = *(const LAS bf16x8*)(sAtt + (mt * 16 + fr) * 72 + ks * 32 + fq * 8); const bf16x8 a2 = *(const LAS bf16x8*)(sQt + (mt * 16 + fr) * 72 + ks * 32 + fq * 8);
#pragma unroll
        for (int q = 0; q < 4; ++q) { const int nt = nt4 + q;
            const bf16x8 bv = *(const LAS bf16x8*)(sVT + (nt * 16 + fr) * 72 + ks * 32 + fq * 8);
            o[q] = __builtin_amdgcn_mfma_f32_16x16x32_bf16(a1, bv, o[q], 0, 0, 0); o[q] = __builtin_amdgcn_mfma_f32_16x16x32_bf16(a2, U.bs[q][ks], o[q], 0, 0, 0); } }
    float p[4];
#pragma unroll
    for (int j = 0; j < 4; ++j) { float s = 0.f;
#pragma unroll
        for (int q = 0; q < 4; ++q) s += o[q][j] * o[q][j];
        s += __shfl_xor(s, 1); s += __shfl_xor(s, 2); s += __shfl_xor(s, 4); s += __shfl_xor(s, 8); p[j] = s; }
    if (fr == 0) {
#pragma unroll
        for (int j = 0; j < 4; ++j) sSS[(w & 1) * 64 + mt * 16 + fq * 4 + j] = p[j]; }
    __syncthreads();
#pragma unroll
    for (int j = 0; j < 4; ++j) { const int c = mt * 16 + fq * 4 + j; const float rs = rsqrtf((sSS[c] + sSS[64 + c]) * (1.0f / 128.0f) + EPS);
#pragma unroll
        for (int q = 0; q < 4; ++q) { const int vcol = (nt4 + q) * 16 + fr; const float gz = bf2f(U.gzr[j][q]);
            const float val = o[q][j] * rs * gnv[q] * (gz / (1.f + __expf(-gz)));
            F.mix[(size_t)(row0 + c) * D + h * 128 + vcol] = f2bf(val); } }
    __syncthreads();
}
__device__ __forceinline__ void gla_scan_elem(const Frame& F, int l, int e) {
    const int bh = e >> 12, idx = (e & 4095) * 2, k = idx & 63, vcol = idx >> 6;
    const float* kv = F.kvt + (size_t)bh * 32 * 8192 + idx; const float* dc = F.dec + bh * 32 * 64 + k; bf16_t* st = F.st + (size_t)bh * 32 * 8192 + idx;
    f32x2 S = (f32x2){0.f, 0.f};
#pragma unroll 8
    for (int n = 0; n < 32; ++n) { *(unsigned*)(st + (size_t)n * 8192) = cvtpk(S[0], S[1]);
        const f32x2 d = *(const f32x2*)(dc + n * 64), x = *(const f32x2*)(kv + (size_t)n * 8192); S = d * S + x; }
    float* o = F.out + O_GLAP + ((size_t)l * 32 + bh) * 8192 + k * 128 + vcol;
    o[0] = S[0]; o[128] = S[1];
}
__device__ __forceinline__ void gla_scan(const Frame& F, int l) {
    if (F.G == 256) { const int b = F.bid & 7, j = F.bid >> 3; gla_scan_elem(F, l, (b * 4 + (j >> 3)) * 4096 + (j & 7) * 512 + F.tid); }
    else for (int e = F.bid * 512 + F.tid; e < 32 * 4096; e += F.G * 512) gla_scan_elem(F, l, e);
}
__device__ __forceinline__ void gla_out_unit(const Frame& F, int l, int unit) {
    const int bh = unit >> 5, n = unit & 31, b = bh >> 2, h = bh & 3, row0 = b * SEQ + n * 64;
    const bf16_t* zrow0 = F.z + (size_t)row0 * ZLD;
    LAS float* sSS = (LAS float*)(F.lds + L_SS); LAS bf16_t* sAtt = (LAS bf16_t*)(F.lds + L_ATT);
    const int w = F.wave, fr = F.lane & 15, fq = F.lane >> 4, mt = w >> 1, hf = w & 1, nt4 = hf * 4;
    const bf16_t* qtg = F.qt + (size_t)unit * 4096; const bf16_t* ktg = F.kt + (size_t)unit * 4096; const bf16_t* vtg = F.vt + (size_t)unit * 8192; const bf16_t* stg = F.st + (size_t)unit * 8192;
    bf16x8 aq[2], bk[2][2], bv[4][2], bs[4][2];
#pragma unroll
    for (int ks = 0; ks < 2; ++ks) aq[ks] = *(const bf16x8*)(qtg + (mt * 16 + fr) * 64 + ks * 32 + fq * 8);
#pragma unroll
    for (int q = 0; q < 2; ++q)
#pragma unroll
        for (int ks = 0; ks < 2; ++ks) bk[q][ks] = *(const bf16x8*)(ktg + ((hf * 2 + q) * 16 + fr) * 64 + ks * 32 + fq * 8);
#pragma unroll
    for (int q = 0; q < 4; ++q)
#pragma unroll
        for (int ks = 0; ks < 2; ++ks) { bv[q][ks] = *(const bf16x8*)(vtg + ((nt4 + q) * 16 + fr) * 64 + ks * 32 + fq * 8); bs[q][ks] = *(const bf16x8*)(stg + ((nt4 + q) * 16 + fr) * 64 + ks * 32 + fq * 8); }
    bf16_t gzr[4][4];
#pragma unroll
    for (int jj = 0; jj < 4; ++jj)
#pragma unroll
        for (int q = 0; q < 4; ++q) gzr[jj][q] = zrow0[(size_t)(mt * 16 + fq * 4 + jj) * ZLD + ZG + h * 128 + (nt4 + q) * 16 + fr];
    float gnv[4];
#pragma unroll
    for (int q = 0; q < 4; ++q) gnv[q] = F.gla_norm_g[l * 128 + (nt4 + q) * 16 + fr];
#pragma unroll
    for (int q = 0; q < 2; ++q) { const int nt = hf * 2 + q;
        f32x4 acc = (f32x4){0.f, 0.f, 0.f, 0.f};
        if (nt <= mt) {
#pragma unroll
            for (int ks = 0; ks < 2; ++ks) acc = __builtin_amdgcn_mfma_f32_16x16x32_bf16(aq[ks], bk[q][ks], acc, 0, 0, 0); }
#pragma unroll
        for (int jj = 0; jj < 4; ++jj) { const int c = mt * 16 + fq * 4 + jj, sc = nt * 16 + fr; sAtt[c * 72 + sc] = f2bf(sc <= c ? acc[jj] : 0.f); } }
    __syncthreads();
    f32x4 o[4];
#pragma unroll
    for (int q = 0; q < 4; ++q) o[q] = (f32x4){0.f, 0.f, 0.f, 0.f};
#pragma unroll
    for (int ks = 0; ks < 2; ++ks) {
        const bf16x8 a1 = *(const LAS bf16x8*)(sAtt + (mt * 16 + fr) * 72 + ks * 32 + fq * 8);
#pragma unroll
        for (int q = 0; q < 4; ++q) { o[q] = __builtin_amdgcn_mfma_f32_16x16x32_bf16(a1, bv[q][ks], o[q], 0, 0, 0); o[q] = __builtin_amdgcn_mfma_f32_16x16x32_bf16(aq[ks], bs[q][ks], o[q], 0, 0, 0); } }
    float p[4];
#pragma unroll
    for (int jj = 0; jj < 4; ++jj) { float sq = 0.f;
#pragma unroll
        for (int q = 0; q < 4; ++q) sq += o[q][jj] * o[q][jj];
        sq += __shfl_xor(sq, 1); sq += __shfl_xor(sq, 2); sq += __shfl_xor(sq, 4); sq += __shfl_xor(sq, 8); p[jj] = sq; }
    if (fr == 0) {
#pragma unroll
        for (int jj = 0; jj < 4; ++jj) sSS[hf * 64 + mt * 16 + fq * 4 + jj] = p[jj]; }
    __syncthreads();
#pragma unroll
    for (int jj = 0; jj < 4; ++jj) { const int c = mt * 16 + fq * 4 + jj; const float rs = rsqrtf((sSS[c] + sSS[64 + c]) * (1.0f / 128.0f) + EPS);
#pragma unroll
        for (int q = 0; q < 4; ++q) { const int vcol = (nt4 + q) * 16 + fr; const float gz = bf2f(gzr[jj][q]);
            F.mix[(size_t)(row0 + c) * D + h * 128 + vcol] = f2bf(o[q][jj] * rs * gnv[q] * (gz / (1.f + __expf(-gz)))); } }
    __syncthreads();
}
__device__ __forceinline__ void gla_decode_unit(const Frame& F, int l, int unit) {
    const int s = unit >> 2, h = unit & 3, row = MP + s, tid = F.tid;
    const bf16_t* zrow = F.z + (size_t)row * ZLD;
    LAS float* sA = (LAS float*)(F.lds); LAS float* sQ = sA + 64; LAS float* sK = sA + 128; LAS float* sO = sA + 192; LAS float* sRed = sA + 192 + 512;
    const int v = tid & 127, kg = tid >> 7;
    const size_t soff = (((size_t)l * 128 + s) * 4 + h) * 8192;
    const float* S0 = F.state_gla + soff; float* Sn = F.out + O_GLAS + soff;
    float s0r[16];
#pragma unroll
    for (int i = 0; i < 16; ++i) s0r[i] = S0[(kg * 16 + i) * 128 + v];
    const float vv = bf2f(zrow[ZV + h * 128 + v]); const float gzv = bf2f(zrow[ZG + h * 128 + v]);
    if (tid < 64) { const int j = tid; const float* wg = F.w_gate + (size_t)l * 16 * 256 + h * 64 + j; float ga = F.b_gate[l * 256 + h * 64 + j];
#pragma unroll
        for (int r = 0; r < 16; ++r) ga += F.alow[(size_t)row * 16 + r] * wg[r * 256];
        sA[j] = __expf(logsig(ga) * (1.0f / 16.0f)); sQ[j] = bf2f(zrow[ZQ + h * 64 + j]); sK[j] = bf2f(zrow[ZK + h * 64 + j]); }
    __syncthreads();
    float po = 0.f;
#pragma unroll 16
    for (int i = 0; i < 16; ++i) { const int k = kg * 16 + i; const float sn = sA[k] * s0r[i] + sK[k] * vv; Sn[k * 128 + v] = sn; po += sQ[k] * sn; }
    sO[kg * 128 + v] = po;
    __syncthreads();
    float o = 0.f;
    if (tid < 128) { o = 0.125f * ((sO[v] + sO[128 + v]) + (sO[256 + v] + sO[384 + v])); const float sq = wave_sum(o * o); if (F.lane == 0) sRed[F.wave] = sq; }
    __syncthreads();
    if (tid < 128) { const float rs = rsqrtf((sRed[0] + sRed[1]) * (1.0f / 128.0f) + EPS); const float gz = gzv;
        F.mix[(size_t)row * D + h * 128 + v] = f2bf(o * rs * F.gla_norm_g[l * 128 + v] * (gz / (1.f + __expf(-gz)))); }
    __syncthreads();
}
constexpr int L_U = 0, L_P = 40448;
struct PoolB { bf16x8 b[4][4]; float sc[4]; };
__device__ __forceinline__ void pool_load_b(const Frame& F, int l, int g, PoolB& P) {
    const int w = F.wave, fr = F.lane & 15, fq = F.lane >> 4, nt4 = (w & 1) * 4;
    const bf16_t* pw = wptr(F, l, W_POOL) + g * 16384;
#pragma unroll
    for (int q = 0; q < 4; ++q) {
#pragma unroll
        for (int ks = 0; ks < 4; ++ks) P.b[q][ks] = *(const bf16x8*)(pw + ((nt4 + q) * 16 + fr) * 128 + ks * 32 + fq * 8);
        P.sc[q] = F.pool_scale[l * 512 + g * 128 + (nt4 + q) * 16 + fr]; }
}
__device__ __forceinline__ void pool_mma_store(const Frame& F, int g, int row0, const PoolB& P) {
    LAS bf16_t* sP = (LAS bf16_t*)(F.lds + L_P);
    const int w = F.wave, fr = F.lane & 15, fq = F.lane >> 4, mt = w >> 1, nt4 = (w & 1) * 4;
    f32x4 acc[4];
#pragma unroll
    for (int q = 0; q < 4; ++q) acc[q] = (f32x4){0.f, 0.f, 0.f, 0.f};
#pragma unroll
    for (int ks = 0; ks < 4; ++ks) { const bf16x8 a = *(const LAS bf16x8*)(sP + (mt * 16 + fr) * 136 + ks * 32 + fq * 8);
#pragma unroll
        for (int q = 0; q < 4; ++q) acc[q] = __builtin_amdgcn_mfma_f32_16x16x32_bf16(a, P.b[q][ks], acc[q], 0, 0, 0); }
#pragma unroll
    for (int q = 0; q < 4; ++q) { const int d = (nt4 + q) * 16 + fr;
#pragma unroll
        for (int j = 0; j < 4; ++j) F.mix[(size_t)(row0 + mt * 16 + fq * 4 + j) * D + 512 + g * 128 + d] = f2bf(acc[q][j] * P.sc[q]); }
}
struct PoolU { u32x4 uv[3]; };
__device__ __forceinline__ void pool_prompt_load(const Frame& F, int unit, PoolU& U) {
    const int g = unit & 3, bn = unit >> 2, n = bn & 31, b = bn >> 5, t0 = n * 64, tid = F.tid, cg8 = tid & 15;
#pragma unroll
    for (int pass = 0; pass < 3; ++pass) { const int i = (tid >> 4) + pass * 32, t = t0 - 15 + i;
        U.uv[pass] = (u32x4){0u, 0u, 0u, 0u}; if (i < 79 && t >= 0) U.uv[pass] = *(const u32x4*)(F.z + (size_t)(b * SEQ + t) * ZLD + ZU + g * 128 + cg8 * 8); }
}
__device__ __forceinline__ void pool_prompt_unit(const Frame& F, int l, int unit, const PoolU& U, const PoolB& PB) {
    const int g = unit & 3, bn = unit >> 2, n = bn & 31, b = bn >> 5, t0 = n * 64, row0 = b * SEQ + t0, tid = F.tid;
    LAS float* sU = (LAS float*)(F.lds + L_U); LAS bf16_t* sP = (LAS bf16_t*)(F.lds + L_P);
    { const int cg8 = tid & 15;
#pragma unroll
      for (int pass = 0; pass < 3; ++pass) { const int i = (tid >> 4) + pass * 32; if (i < 79) {
          { const u32x4 uu = U.uv[pass]; *(LAS f32x4*)(sU + i * 128 + cg8 * 8) = (f32x4){bflo(uu.x), bfhi(uu.x), bflo(uu.y), bfhi(uu.y)}; *(LAS f32x4*)(sU + i * 128 + cg8 * 8 + 4) = (f32x4){bflo(uu.z), bfhi(uu.z), bflo(uu.w), bfhi(uu.w)}; } } } }
    __syncthreads();
    { const int c = tid & 127, tg = tid >> 7, wdw = 2 << g;
      float s = 0.f; const int i0 = tg * 16 + 15;
      for (int d = 1; d < wdw; ++d) s += sU[(i0 - d) * 128 + c];
#pragma unroll 4
      for (int tt = 0; tt < 16; ++tt) { const int i = i0 + tt; const float u = sU[i * 128 + c]; s += u; const int t = t0 + tg * 16 + tt; const float cnt = (float)min(wdw, t + 1);
          sP[(tg * 16 + tt) * 136 + c] = f2bf(s / cnt - u); s -= sU[(i - wdw + 1) * 128 + c]; }
      if (n == 31 && tid < 128) {
#pragma unroll
          for (int j = 0; j < 15; ++j) F.out[O_POOLP + (((size_t)l * 8 + b) * 15 + j) * 512 + g * 128 + c] = sU[(64 + j) * 128 + c]; } }
    __syncthreads();
    pool_mma_store(F, g, row0, PB);
    __syncthreads();
}
__device__ __forceinline__ void pool_sample_unit(const Frame& F, int l, int unit) {
    const int g = unit & 3, sblk = unit >> 2, tid = F.tid, c = tid & 127, sg = tid >> 7, wdw = 2 << g;
    LAS bf16_t* sP = (LAS bf16_t*)(F.lds + L_P);
    const int w = F.wave, fr = F.lane & 15, fq = F.lane >> 4;
    bf16x8 bfr[4];
    { const bf16_t* pw = wptr(F, l, W_POOL) + g * 16384;
#pragma unroll
      for (int ks = 0; ks < 4; ++ks) bfr[ks] = *(const bf16x8*)(pw + (w * 16 + fr) * 128 + ks * 32 + fq * 8); }
    const float sc = F.pool_scale[l * 512 + g * 128 + w * 16 + fr];
    float pv[4][15]; float uv[4];
#pragma unroll
    for (int i = 0; i < 4; ++i) { const int s = sblk * 16 + sg * 4 + i;
        const float* sp = F.state_pool + (((size_t)l * 128 + s) * 15) * 512 + g * 128 + c;
        uv[i] = bf2f(F.z[(size_t)(MP + s) * ZLD + ZU + g * 128 + c]);
#pragma unroll
        for (int j = 0; j < 15; ++j) pv[i][j] = sp[j * 512]; }
#pragma unroll
    for (int i = 0; i < 4; ++i) { const int sl = sg * 4 + i, s = sblk * 16 + sl;
        float* so = F.out + O_POOLS + (((size_t)l * 128 + s) * 15) * 512 + g * 128 + c;
        float sum = uv[i];
#pragma unroll
        for (int j = 0; j < 15; ++j) { if (j >= 16 - wdw) sum += pv[i][j]; if (j >= 1) so[(j - 1) * 512] = pv[i][j]; }
        so[14 * 512] = uv[i];
        sP[sl * 136 + c] = f2bf(sum / (float)wdw - uv[i]); }
    __syncthreads();
    f32x4 acc = (f32x4){0.f, 0.f, 0.f, 0.f};
#pragma unroll
    for (int ks = 0; ks < 4; ++ks) { const bf16x8 a = *(const LAS bf16x8*)(sP + fr * 136 + ks * 32 + fq * 8); acc = __builtin_amdgcn_mfma_f32_16x16x32_bf16(a, bfr[ks], acc, 0, 0, 0); }
#pragma unroll
    for (int j = 0; j < 4; ++j) F.mix[(size_t)(MP + sblk * 16 + fq * 4 + j) * D + 512 + g * 128 + w * 16 + fr] = f2bf(acc[j] * sc);
    __syncthreads();
}

__device__ __forceinline__ int gla_unit_at(int bid, int G, int k) { if (G != 256) return bid + k * G; const int b = bid & 7, j = bid >> 3; return ((b * 4 + (j & 3)) << 5) | ((j >> 2) * 4 + k); }
__device__ __forceinline__ int pool_unit_at(int bid, int G, int k) { if (G != 256) return bid + k * G; const int b = bid & 7, j = bid >> 3; return ((b * 32 + (j >> 2) * 4 + k) << 2) | (j & 3); }
__device__ __forceinline__ int units_of(int bid, int G) { return G == 256 ? 4 : (1024 - bid + G - 1) / G; }

__global__ void __launch_bounds__(512, 2) hymba_fwd(Args args) {
    extern __shared__ __attribute__((aligned(16))) unsigned char lds_raw[];
    cg::grid_group grid = cg::this_grid();
    typedef const __attribute__((address_space(4))) Args* KArgs;
    const KArgs ap0 = (KArgs)__builtin_amdgcn_kernarg_segment_ptr();
    const int ph_lo = ap0->ph_lo, ph_hi = ap0->ph_hi, coop = ap0->coop;
    for (int u = threadIdx.x; u < (LDS_BYTES - 131072) / 4; u += 512) ((LAS unsigned*)((LAS unsigned char*)lds_raw + 131072))[u] = 0u;
    __syncthreads();
    if (coop) (void)xcd_barrier_post((unsigned*)(ap0->ws + WS_CTL), (volatile LAS unsigned*)((LAS unsigned char*)lds_raw + MISC_OFF) + 8);
#ifndef PROBE_REP
#define PROBE_REP 0
#endif
    for (int ph = ph_lo; ph < ph_hi; ++ph) {
    const int sub_ = (ph == 0) ? -1 : (ph - 1) % 7; const int nrep = (ph == NPHASE - 1) ? 1 : ((ph == 0) ? ((PROBE_REP & 1) ? 2 : 1) : ((sub_ == 0 && (PROBE_REP & 2)) || (sub_ == 1 && (PROBE_REP & 4)) || (sub_ == 2 && (PROBE_REP & 8)) || (sub_ == 3 && (PROBE_REP & 16)) || (sub_ == 5 && (PROBE_REP & 32))) ? 2 : 1);
    for (int rep_ = 0; rep_ < nrep; ++rep_) {
    int tid_ = threadIdx.x; asm volatile("" : "+v"(tid_));
    KArgs ap = ap0; asm volatile("" : "+s"(ap));
    unsigned char* ws_ = ap->ws; float* out_ = ap->out;
    Frame F;
    F.lds = (LAS unsigned char*)lds_raw; F.tid = tid_; F.lane = F.tid & 63; F.wave = __builtin_amdgcn_readfirstlane(F.tid >> 6); F.G = gridDim.x; F.bid = blockIdx.x;
    F.x_prompt = ap->in[0]; F.x_sample = ap->in[1]; F.state_gla = ap->in[2]; F.state_pool = ap->in[3]; F.norm1_g = ap->in[4]; F.w_in = ap->in[5]; F.w_gate = ap->in[6]; F.b_gate = ap->in[7];
    F.gla_norm_g = ap->in[8]; F.pool_w = ap->in[9]; F.pool_scale = ap->in[10]; F.w_out = ap->in[11]; F.norm2_g = ap->in[12]; F.w_up = ap->in[13]; F.w_down = ap->in[14]; F.final_g = ap->in[15];
    F.out = out_; F.ws = ws_;
    F.rsp = (float*)(F.ws + WS_RSP); F.rss = (float*)(F.ws + WS_RSS); F.alow = (float*)(F.ws + WS_ALOW); F.dec = (float*)(F.ws + WS_DEC); F.kvt = (float*)(F.ws + WS_KVT);
    F.xb = (bf16_t*)(F.ws + WS_XB); F.z = (bf16_t*)(F.ws + WS_Z); F.mix = (bf16_t*)(F.ws + WS_MIX); F.hid = (bf16_t*)(F.ws + WS_HID); F.st = (bf16_t*)(F.ws + WS_ST);
    F.qt = (bf16_t*)(F.ws + WS_QKV); F.kt = F.qt + (size_t)1024 * 4096; F.vt = F.kt + (size_t)1024 * 4096;
        if (ph == 0) {
            p0_prologue(F);
        } else if (ph == NPHASE - 1) {
            const int gw = F.bid * 8 + F.wave, NGW = F.G * 8;
            for (int m = gw; m < MT; m += NGW) { const u32x2* xr = (const u32x2*)(F.xb + (size_t)m * D) + F.lane; f32x4* yo = (f32x4*)(F.out + (size_t)m * D) + F.lane; const f32x4* gr = (const f32x4*)F.final_g + F.lane;
                const float part = m < MP ? (F.lane < 16 ? F.rsp[((size_t)8 * MP + m) * 16 + F.lane] : 0.f) : F.rss[((size_t)8 * 128 + (m - MP)) * 64 + F.lane];
                const float rs = rsqrtf(wave_sum(part) * (1.0f / D) + EPS);
#pragma unroll
                for (int j = 0; j < 4; ++j) { const u32x2 xw = xr[64 * j]; f32x4 v = (f32x4){bflo(xw.x), bfhi(xw.x), bflo(xw.y), bfhi(xw.y)}; v = v * rs * gr[64 * j]; yo[64 * j] = v; } }
        } else {
            const int l = (ph - 1) / 7, sub = (ph - 1) % 7;
            if (sub == 0) {
                const float* ssp = F.rsp + (size_t)(2 * l) * MP * 16; const float* sss = F.rss + (size_t)(2 * l) * 128 * 64;
                { pg8::Gemm g{F.xb, wptr(F, l, W_IN), MP, ZLD, D}; pg8::StaticOrder S; S.init(MP, ZLD, F.G, F.bid);
                  pg8::EpiScaleBf16<0> E{F.z, ZLD, ssp};
                  pg8::gemm_phase<pg8::EpiScaleBf16<0>, pg8::StaticOrder, true, true>(F.lds, g, S, E, F.tid); }
                for (int u = F.bid; u < 129 + 128; u += F.G) {
                    if (u < 128) { SkAlow<16> E{F.alow + (size_t)u * 128 * 16, ssp + (size_t)u * 128 * 16}; skinny_unit<8, 2>(F.lds, F.xb + (size_t)u * 128 * D, D, wptr(F, l, W_IN) + (size_t)2048 * D, D, E, F.tid); }
                    else if (u == 128) { SkAlow<64> E{F.alow + (size_t)u * 128 * 16, sss}; skinny_unit<8, 2>(F.lds, F.xb + (size_t)u * 128 * D, D, wptr(F, l, W_IN) + (size_t)2048 * D, D, E, F.tid); }
                    else { const int j = u - 129; SkScaleBf16<0> E{F.z + (size_t)MP * ZLD + j * 16, ZLD, sss}; skinny_unit<8, 2>(F.lds, F.xb + (size_t)MP * D, D, wptr(F, l, W_IN) + (size_t)j * 16 * D, D, E, F.tid); }
                }
            } else if (sub == 1) {
                { KvC C; KvU U0; const int nu = units_of(F.bid, F.G);
                  const int u0 = gla_unit_at(min(F.bid, 1023), F.G, 0); gla_kv_loadc(F, l, (u0 >> 5) & 3, C); gla_kv_load(F, u0, U0);
                  for (int k = 0; k < nu; ++k) { const int u = gla_unit_at(F.bid, F.G, k); if (F.G != 256) gla_kv_loadc(F, l, (u >> 5) & 3, C);
                      KvU U1; if (k + 1 < nu) gla_kv_load(F, gla_unit_at(F.bid, F.G, k + 1), U1); else U1 = U0;
                      gla_kv_unit(F, l, u, C, U0); U0 = U1; } }
            } else if (sub == 2) {
                { PoolB PB; PoolU U0; const int nu = units_of(F.bid, F.G);
                  const int u0 = pool_unit_at(min(F.bid, 1023), F.G, 0); pool_load_b(F, l, u0 & 3, PB); pool_prompt_load(F, u0, U0);
                  gla_scan(F, l);
                  for (int k = 0; k < nu; ++k) { const int u = pool_unit_at(F.bid, F.G, k); if (F.G != 256) pool_load_b(F, l, u & 3, PB);
                      PoolU U1; if (k + 1 < nu) pool_prompt_load(F, pool_unit_at(F.bid, F.G, k + 1), U1); else U1 = U0;
                      pool_prompt_unit(F, l, u, U0, PB); U0 = U1; } }
                for (int u = 1024 + F.bid; u < 1024 + 32 + 512; u += F.G) {
                    if (u < 1056) pool_sample_unit(F, l, u - 1024); else gla_decode_unit(F, l, u - 1056);
                }
            } else if (sub == 3) {
                { OutU U0; float gnv[4];
#pragma unroll
                  for (int q = 0; q < 4; ++q) gnv[q] = F.gla_norm_g[l * 128 + ((F.wave & 1) * 4 + q) * 16 + (F.lane & 15)];
                  const int nu = units_of(F.bid, F.G); gla_out_load(F, gla_unit_at(min(F.bid, 1023), F.G, 0), U0);
                  for (int k = 0; k < nu; ++k) { const int u = gla_unit_at(F.bid, F.G, k); OutU U1; if (k + 1 < nu) gla_out_load(F, gla_unit_at(F.bid, F.G, k + 1), U1); else U1 = U0;
                      gla_out_unit_v3(F, l, u, U0, gnv); U0 = U1; } }
            } else if (sub == 4) {
                float* ssp = F.rsp + (size_t)(2 * l + 1) * MP * 16; float* sss = F.rss + (size_t)(2 * l + 1) * 128 * 64;
                { pg8::Gemm g{F.mix, wptr(F, l, W_OUT), MP, D, D}; pg8::StaticOrder S; S.init(MP, D, F.G, F.bid);
                  pg8::EpiRes E{F.xb, ssp};
                  pg8::gemm_phase<pg8::EpiRes, pg8::StaticOrder, true, true>(F.lds, g, S, E, F.tid); }
                for (int uu = F.bid; uu < 256; uu += F.G) { const int u = uu & 63, r0 = MP + (uu >> 6) * 32; SkRes E{F.xb + (size_t)r0 * D + u * 16, sss + (size_t)(r0 - MP) * 64, u}; skinny_unit<2, 4>(F.lds, F.mix + (size_t)r0 * D, D, wptr(F, l, W_OUT) + (size_t)u * 16 * D, D, E, F.tid); }
            } else if (sub == 5) {
                const float* ssp = F.rsp + (size_t)(2 * l + 1) * MP * 16; const float* sss = F.rss + (size_t)(2 * l + 1) * 128 * 64;
                { pg8::Gemm g{F.xb, wptr(F, l, W_UP), MP, FF, D}; pg8::StaticOrder S; S.init(MP, FF, F.G, F.bid);
                  pg8::EpiScaleBf16<1> E{F.hid, FF, ssp};
                  pg8::gemm_phase<pg8::EpiScaleBf16<1>, pg8::StaticOrder, true, true>(F.lds, g, S, E, F.tid); }
                for (int u = F.bid; u < 256; u += F.G) { SkScaleBf16<1> E{F.hid + (size_t)MP * FF + u * 16, FF, sss}; skinny_unit<8, 2>(F.lds, F.xb + (size_t)MP * D, D, wptr(F, l, W_UP) + (size_t)u * 16 * D, D, E, F.tid); }
            } else {
                float* ssp = F.rsp + (size_t)(2 * l + 2) * MP * 16; float* sss = F.rss + (size_t)(2 * l + 2) * 128 * 64;
                { pg8::Gemm g{F.hid, wptr(F, l, W_DOWN), MP, D, FF}; pg8::StaticOrder S; S.init(MP, D, F.G, F.bid);
                  pg8::EpiRes E{F.xb, ssp};
                  pg8::gemm_phase<pg8::EpiRes, pg8::StaticOrder, true, true>(F.lds, g, S, E, F.tid); }
                for (int uu = F.bid; uu < 256; uu += F.G) { const int u = uu & 63, r0 = MP + (uu >> 6) * 32; SkRes E{F.xb + (size_t)r0 * D + u * 16, sss + (size_t)(r0 - MP) * 64, u}; skinny_unit<2, 8>(F.lds, F.hid + (size_t)r0 * FF, FF, wptr(F, l, W_DOWN) + (size_t)u * 16 * FF, FF, E, F.tid); }
            }
        }
        }
        if (ph + 1 < ph_hi) { if (coop) { if (ph == 0) grid.sync(); else { KArgs apb = ap0; asm volatile("" : "+s"(apb)); XcdBarrier xbar; xbar.bar = (unsigned*)(apb->ws + WS_CTL); xbar.x = xb_xcc_id(); xbar.st = (volatile LAS unsigned*)((LAS unsigned char*)lds_raw + MISC_OFF) + 8; xcd_barrier(xbar); if (PROBE_REP & 64) xcd_barrier(xbar); } } }
    }
}

#ifndef ONE_LAUNCH
#define ONE_LAUNCH 1
#endif
extern "C" void kernel_launch(void* const* d_in, const int* in_sizes, int n_in, void* d_out, int out_size, void* d_ws, size_t ws_size, hipStream_t stream) {
    static int grid = 0;
    if (grid == 0) {
        if (n_in != 16 || ws_size < WS_END) { fprintf(stderr, "kernel_launch: need 16 inputs and >= %zu bytes of workspace (got %d, %zu)\n", (size_t)WS_END, n_in, ws_size); grid = -1; return; }
        int dev = 0, cus = 0, per_cu = 0;
        hipGetDevice(&dev); hipDeviceGetAttribute(&cus, hipDeviceAttributeMultiprocessorCount, dev);
        if (hipFuncSetAttribute((const void*)hymba_fwd, hipFuncAttributeMaxDynamicSharedMemorySize, LDS_BYTES) != hipSuccess) { fprintf(stderr, "kernel_launch: hipFuncSetAttribute failed\n"); grid = -1; return; }
        if (hipOccupancyMaxActiveBlocksPerMultiprocessor(&per_cu, (const void*)hymba_fwd, 512, LDS_BYTES) != hipSuccess || per_cu < 1) { fprintf(stderr, "kernel_launch: occupancy query says %d\n", per_cu); per_cu = 1; }
        (void)hipGetLastError();
        grid = cus;
    }
    if (grid < 0) return;
    if (hipMemsetAsync((char*)d_ws + WS_CTL, 0, CTL_ZERO_BYTES, stream) != hipSuccess) { fprintf(stderr, "kernel_launch: hipMemsetAsync failed\n"); return; }
    Args a{};
    for (int i = 0; i < 16; ++i) a.in[i] = (const float*)d_in[i];
    a.out = (float*)d_out; a.ws = (unsigned char*)d_ws;
#if ONE_LAUNCH
    a.ph_lo = 0; a.ph_hi = NPHASE; a.coop = 1;
    void* kargs[] = {&a};
    hipError_t e = hipLaunchCooperativeKernel((const void*)hymba_fwd, dim3(grid), dim3(512), kargs, LDS_BYTES, stream);
    if (e != hipSuccess) fprintf(stderr, "cooperative launch failed: %s (grid %d)\n", hipGetErrorString(e), grid);
#else
    for (int ph = 0; ph < NPHASE; ++ph) { a.ph_lo = ph; a.ph_hi = ph + 1; a.coop = 0; hipLaunchKernelGGL(hymba_fwd, dim3(grid), dim3(512), LDS_BYTES, stream, a); }
#endif
}
```

```cpp
#include <hip/hip_runtime.h>
#include <hip/hip_cooperative_groups.h>
#include <cstdio>
#include <cstdint>
namespace cg = cooperative_groups;

#define LAS __attribute__((address_space(3)))
typedef unsigned short bf16_t;
typedef short bf16x8 __attribute__((ext_vector_type(8)));
typedef float f32x4 __attribute__((ext_vector_type(4)));
typedef float f32x2 __attribute__((ext_vector_type(2)));
typedef __bf16 bf16x2n __attribute__((ext_vector_type(2)));
typedef unsigned u32x4 __attribute__((ext_vector_type(4)));
typedef unsigned u32x2 __attribute__((ext_vector_type(2)));

constexpr int D = 1024, SEQ = 2048, NBATCH = 8, MP = NBATCH * SEQ, MS = 128, MT = MP + MS, DEPTH = 4;
constexpr int FF = 4096, INW = 2064, ZLD = 2048;
constexpr float EPS = 1e-6f;
constexpr int ZQ = 0, ZK = 256, ZV = 512, ZG = 1024, ZU = 1536;
constexpr size_t O_GLAP = (size_t)MT * D, O_POOLP = O_GLAP + 4 * 8 * 4 * 64 * 128, O_GLAS = O_POOLP + 4 * 8 * 15 * 512, O_POOLS = O_GLAS + (size_t)4 * 128 * 4 * 64 * 128;
constexpr size_t MiB = 1u << 20;
constexpr size_t WS_ALOW = 1 * MiB, WS_DEC = 3 * MiB, WS_W = 4 * MiB, W_STRIDE = 23 * MiB;
constexpr size_t W_IN = 0, W_OUT = 4 * MiB + 512 * 1024, W_UP = W_OUT + 2 * MiB, W_DOWN = W_UP + 8 * MiB, W_POOL = W_DOWN + 8 * MiB;
constexpr size_t WS_XB = 96 * MiB, WS_Z = 129 * MiB, WS_MIX = 194 * MiB, WS_HID = 129 * MiB, WS_KVT = 227 * MiB, WS_ST = 259 * MiB, WS_RSP = 275 * MiB, WS_RSS = 284 * MiB, WS_QKV = 285 * MiB, WS_END = 317 * MiB;
static_assert(W_POOL + 128 * 1024 <= W_STRIDE && WS_W + 4 * W_STRIDE <= WS_XB, "weight map");
constexpr int LDS_BYTES = 147456, MISC_OFF = 131072 + 320;
constexpr size_t WS_CTL = 0, CTL_ZERO_BYTES = 16384;
constexpr int NPHASE = 2 + 7 * DEPTH;

__device__ __forceinline__ unsigned cvtpk(float lo, float hi) { f32x2 v = {lo, hi}; bf16x2n b = __builtin_convertvector(v, bf16x2n); return __builtin_bit_cast(unsigned, b); }
__device__ __forceinline__ bf16_t f2bf(float f) { return (bf16_t)(cvtpk(f, 0.f) & 0xffffu); }
__device__ __forceinline__ float bf2f(bf16_t h) { return __uint_as_float((unsigned)h << 16); }
__device__ __forceinline__ float bflo(unsigned w) { return __uint_as_float(w << 16); }
__device__ __forceinline__ float bfhi(unsigned w) { return __uint_as_float(w & 0xffff0000u); }
__device__ __forceinline__ float wave_sum(float v) {
#pragma unroll
    for (int o = 1; o < 64; o <<= 1) v += __shfl_xor(v, o);
    return v;
}
#define LDS_WAIT() asm volatile("s_waitcnt lgkmcnt(0)" ::: "memory")

namespace pg8 {
constexpr int BM = 256, BK = 64, HALF = 128, HTB = HALF * BK * 2, STAGE_BYTES = 8 * HTB, NXCD = 8, WGM = 8;
__host__ __device__ __forceinline__ int lds_byte(int r, int c) { const int st = (r >> 4) * 2 + (c >> 5), rr = r & 15, cc = c & 31, ob = rr * 64 + cc * 2; return st * 1024 + (ob ^ (((ob >> 9) & 1) << 5)); }
__host__ __device__ __forceinline__ void stage_rc(int b, int& R, int& C) { const int st = b / 1024, sb = b % 1024, swz = sb ^ (((sb >> 9) & 1) << 5); R = (st >> 1) * 16 + swz / 64; C = (st & 1) * 32 + (swz % 64) / 2; }
__host__ __device__ __forceinline__ int perm32(int rho) { const int n = rho >> 4, i = rho & 15; return 8 * (i >> 2) + 4 * n + (i & 3); }
struct Unit { int pm, pn; };
struct Gemm { const bf16_t* A; const bf16_t* Bt; int M, N, K; };
struct StaticOrder {
    int nM, nN, nwg, G, c;
    __host__ __device__ void init(int M, int N, int G_, int c_) { nM = M / BM; nN = N / BM; nwg = nM * nN; G = G_; c = c_; }
    __host__ __device__ bool next(int i, Unit& u) const {
        const long L = (long)i * G + c; if (L >= nwg) return false;
        int wgid = (int)L; { const int q = nwg / NXCD, r = nwg % NXCD, xcd = wgid % NXCD, off = wgid / NXCD; wgid = (xcd < r ? xcd * (q + 1) : r * (q + 1) + (xcd - r) * q) + off; }
        const int nig = WGM * nN, gid = wgid / nig, fm = gid * WGM, gsz = (nM - fm) < WGM ? (nM - fm) : WGM;
        u.pm = fm + ((wgid % nig) % gsz); u.pn = (wgid % nig) / gsz; return true;
    }
    __device__ __forceinline__ void a_ready(const Unit&) const {}
    __device__ __forceinline__ void done(const Unit&) const {}
};

template <int ACT> struct EpiScaleBf16 {
    static constexpr bool PERM = true, AFTER_DRAIN = false;
    bf16_t* O; int ldc; const float* rowss;
    __device__ __forceinline__ void operator()(const f32x4 (&acc)[2][2][4][2], const Unit& u, int wr, int wc, int fr, int fq) const {
        const int row0 = u.pm * BM + wr * 64 + fr; const int col0 = u.pn * BM + wc * 32 + 8 * fq;
#pragma unroll
        for (int ai = 0; ai < 2; ++ai)
#pragma unroll
            for (int m = 0; m < 4; ++m) {
                const int row = row0 + ai * HALF + m * 16;
                const f32x4 s0 = *(const f32x4*)(rowss + (size_t)row * 16 + fq * 4);
                float tot = (s0[0] + s0[1]) + (s0[2] + s0[3]); tot += __shfl_xor(tot, 16); tot += __shfl_xor(tot, 32);
                const float rs = rsqrtf(tot * (1.0f / D) + EPS);
                bf16_t* rowp = O + (size_t)row * ldc + col0;
#pragma unroll
                for (int bj = 0; bj < 2; ++bj) {
                    f32x4 v0 = acc[ai][bj][m][0] * rs, v1 = acc[ai][bj][m][1] * rs;
                    if (ACT == 1) {
#pragma unroll
                        for (int e = 0; e < 4; ++e) { const float a = fmaxf(v0[e], 0.f), b = fmaxf(v1[e], 0.f); v0[e] = a * a; v1[e] = b * b; }
                    }
                    u32x4 w; w.x = cvtpk(v0[0], v0[1]); w.y = cvtpk(v0[2], v0[3]); w.z = cvtpk(v1[0], v1[1]); w.w = cvtpk(v1[2], v1[3]);
                    *(u32x4*)(rowp + bj * HALF) = w;
                }
            }
    }
};
struct EpiRes {
    static constexpr bool PERM = true, AFTER_DRAIN = false;
    bf16_t* XB; float* ssout;
    __device__ __forceinline__ void operator()(const f32x4 (&acc)[2][2][4][2], const Unit& u, int wr, int wc, int fr, int fq) const {
        const int row0 = u.pm * BM + wr * 64 + fr; const int col0 = u.pn * BM + wc * 32 + 8 * fq;
#pragma unroll
        for (int ai = 0; ai < 2; ++ai)
#pragma unroll
            for (int m = 0; m < 4; ++m) {
                const int row = row0 + ai * HALF + m * 16;
                bf16_t* br = XB + (size_t)row * D + col0;
                float ss = 0.f;
#pragma unroll
                for (int bj = 0; bj < 2; ++bj) {
                    const u32x4 xo = *(const u32x4*)(br + bj * HALF);
                    const f32x4 a0 = acc[ai][bj][m][0], a1 = acc[ai][bj][m][1];
                    u32x4 w; w.x = cvtpk(bflo(xo.x) + a0[0], bfhi(xo.x) + a0[1]); w.y = cvtpk(bflo(xo.y) + a0[2], bfhi(xo.y) + a0[3]);
                    w.z = cvtpk(bflo(xo.z) + a1[0], bfhi(xo.z) + a1[1]); w.w = cvtpk(bflo(xo.w) + a1[2], bfhi(xo.w) + a1[3]);
                    *(u32x4*)(br + bj * HALF) = w;
#pragma unroll
                    for (int e = 0; e < 4; ++e) { const float lo = bflo(w[e]), hi = bfhi(w[e]); ss += lo * lo + hi * hi; }
                }
                ss += __shfl_xor(ss, 16); ss += __shfl_xor(ss, 32);
                if (fq == 0) ssout[(size_t)row * 16 + u.pn * 4 + wc] = ss;
            }
    }
};
template <class Epi, class Sched, bool ALIGN_EPI = false, bool SP2 = false>
__device__ __forceinline__ void gemm_phase(LAS unsigned char* lds, const Gemm g, const Sched& S, const Epi& E, const int tid) {
    const int wid = __builtin_amdgcn_readfirstlane(tid >> 6), lane = tid & 63, wr = wid >> 2, wc = wid & 3, fr = lane & 15, fq = lane >> 4;
    const int K = g.K, nt = K / BK;
    unsigned voffA[2], voffB[2];
#pragma unroll
    for (int i = 0; i < 2; ++i) { int R, C; stage_rc(tid * 16 + i * 8192, R, C); const int Rb = Epi::PERM ? ((R & ~31) + perm32(R & 31)) : R;
        voffA[i] = (unsigned)(R * K + C) * 2u; voffB[i] = (unsigned)(Rb * K + C) * 2u; }
    const size_t kstep = (size_t)(BK * 2);
    const size_t hstep = (size_t)HALF * K * 2;
    const size_t tstep = 2 * hstep;
    const unsigned ldsw = (unsigned)wid * 1024u;
    const int aoff = lds_byte(wr * 64 + fr, fq * 8), boff = lds_byte(wc * 32 + fr, fq * 8);
#define PG8_SA(b, h) (((b) * 2 + (h)) * HTB)
#define PG8_SB(b, h) ((4 + (b) * 2 + (h)) * HTB)
#define PG8_STAGE(bufoff, gbase, voff) do { _Pragma("unroll") for (int _i = 0; _i < 2; ++_i) \
        __builtin_amdgcn_global_load_lds((const unsigned*)((const char*)(gbase) + (voff)[_i]), (LAS unsigned*)(lds + (bufoff) + ldsw + _i * 8192), 16, 0, 0); } while (0)
#define PG8_LDA(dst, b, h) do { _Pragma("unroll") for (int m = 0; m < 4; ++m) _Pragma("unroll") for (int k = 0; k < 2; ++k) dst[m][k] = *(const LAS bf16x8*)(lds + PG8_SA(b, h) + aoff + m * 2048 + k * 1024); } while (0)
#define PG8_LDB(dst, b, h) do { _Pragma("unroll") for (int n = 0; n < 2; ++n) _Pragma("unroll") for (int k = 0; k < 2; ++k) dst[n][k] = *(const LAS bf16x8*)(lds + PG8_SB(b, h) + boff + n * 2048 + k * 1024); } while (0)
#define PG8_MMA(ai, bj, At, Bt) do { __builtin_amdgcn_s_setprio(1); _Pragma("unroll") for (int m = 0; m < 4; ++m) _Pragma("unroll") for (int n = 0; n < 2; ++n) _Pragma("unroll") for (int k = 0; k < 2; ++k) \
        acc[ai][bj][m][n] = __builtin_amdgcn_mfma_f32_16x16x32_bf16(Bt[n][k], At[m][k], acc[ai][bj][m][n], 0, 0, 0); __builtin_amdgcn_s_setprio(0); } while (0)
#define PG8_WAIT_V(n) asm volatile("s_waitcnt vmcnt(" #n ")" ::: "memory")
#define PG8_WAIT_L(n) asm volatile("s_waitcnt lgkmcnt(" #n ")" ::: "memory")
#define PG8_BAR __builtin_amdgcn_s_barrier()
#define PG8_SCHED __builtin_amdgcn_sched_barrier(0)
    Unit cur, nxt; int ui = 0;
    if (!S.next(0, cur)) return;
    f32x4 acc[2][2][4][2];
#pragma unroll
    for (int a = 0; a < 2; ++a)
#pragma unroll
        for (int b = 0; b < 2; ++b)
#pragma unroll
            for (int m = 0; m < 4; ++m)
#pragma unroll
                for (int n = 0; n < 2; ++n) acc[a][b][m][n] = (f32x4){0.f, 0.f, 0.f, 0.f};
    bf16x8 At[4][2], B0[2][2], B1[2][2];
    const char* cA = (const char*)g.A + (size_t)cur.pm * tstep; const char* cB = (const char*)g.Bt + (size_t)cur.pn * tstep;
    S.a_ready(cur);
    if constexpr (SP2) {
        PG8_STAGE(PG8_SB(0, 0), cB, voffB); PG8_STAGE(PG8_SB(0, 1), cB + hstep, voffB); PG8_STAGE(PG8_SA(0, 0), cA, voffA); PG8_STAGE(PG8_SA(0, 1), cA + hstep, voffA);
        if (wr == 1) PG8_BAR;
        PG8_WAIT_V(2); PG8_BAR;
        PG8_STAGE(PG8_SB(1, 0), cB + kstep, voffB); PG8_STAGE(PG8_SA(1, 0), cA + kstep, voffA); PG8_STAGE(PG8_SB(1, 1), cB + hstep + kstep, voffB);
        PG8_WAIT_V(6); PG8_BAR;
    } else {
        PG8_STAGE(PG8_SB(0, 0), cB, voffB); PG8_STAGE(PG8_SA(0, 0), cA, voffA); PG8_STAGE(PG8_SB(0, 1), cB + hstep, voffB); PG8_STAGE(PG8_SA(0, 1), cA + hstep, voffA);
        if (wr == 1) PG8_BAR;
        PG8_WAIT_V(4); PG8_BAR;
        PG8_STAGE(PG8_SB(1, 0), cB + kstep, voffB); PG8_STAGE(PG8_SA(1, 0), cA + kstep, voffA); PG8_STAGE(PG8_SB(1, 1), cB + hstep + kstep, voffB);
        PG8_WAIT_V(6); PG8_BAR;
    }
    for (;;) {
        const bool has_next = S.next(ui + 1, nxt);
        const char* nA = has_next ? (const char*)g.A + (size_t)nxt.pm * tstep : cA; const char* nB = has_next ? (const char*)g.Bt + (size_t)nxt.pn * tstep : cB;
        for (int t = 0; t < nt; t += 2) {
            const bool last = (t == nt - 2);
            const char* a1 = cA + (size_t)(t + 1) * kstep;
            const char* a2 = last ? nA : cA + (size_t)(t + 2) * kstep; const char* b2 = last ? nB : cB + (size_t)(t + 2) * kstep;
            const char* a3 = a2 + kstep; const char* b3 = b2 + kstep;
            if (last && has_next) S.a_ready(nxt);
            if constexpr (SP2) {
            PG8_LDB(B0, 0, 0); PG8_LDB(B1, 0, 1); PG8_SCHED; PG8_LDA(At, 0, 0); PG8_STAGE(PG8_SA(1, 1), a1 + hstep, voffA);
            PG8_WAIT_V(8); PG8_WAIT_L(0); PG8_BAR; PG8_MMA(0, 0, At, B0); PG8_MMA(0, 1, At, B1); PG8_BAR; PG8_SCHED;
            PG8_LDA(At, 0, 1); PG8_STAGE(PG8_SB(0, 0), b2, voffB); PG8_STAGE(PG8_SB(0, 1), b2 + hstep, voffB); PG8_STAGE(PG8_SA(0, 0), a2, voffA);
            PG8_WAIT_V(8); PG8_WAIT_L(0); PG8_BAR; PG8_MMA(1, 0, At, B0); PG8_MMA(1, 1, At, B1); PG8_BAR; PG8_SCHED;
            PG8_LDB(B0, 1, 0); PG8_LDB(B1, 1, 1); PG8_SCHED; PG8_LDA(At, 1, 0); PG8_STAGE(PG8_SA(0, 1), a2 + hstep, voffA);
            PG8_WAIT_V(8); PG8_WAIT_L(0); PG8_BAR; PG8_MMA(0, 0, At, B0); PG8_MMA(0, 1, At, B1); PG8_BAR; PG8_SCHED;
            PG8_LDA(At, 1, 1); PG8_STAGE(PG8_SB(1, 0), b3, voffB); PG8_STAGE(PG8_SB(1, 1), b3 + hstep, voffB); PG8_STAGE(PG8_SA(1, 0), a3, voffA);
            PG8_WAIT_V(8); PG8_WAIT_L(0); PG8_BAR; PG8_MMA(1, 0, At, B0); PG8_MMA(1, 1, At, B1); PG8_BAR; PG8_SCHED;
            } else {
            PG8_LDB(B0, 0, 0); PG8_SCHED; PG8_LDA(At, 0, 0); PG8_STAGE(PG8_SA(1, 1), a1 + hstep, voffA);
            PG8_WAIT_L(8); PG8_BAR; PG8_WAIT_L(0); PG8_MMA(0, 0, At, B0); PG8_BAR; PG8_SCHED;
            PG8_LDB(B1, 0, 1); PG8_STAGE(PG8_SB(0, 0), b2, voffB);
            PG8_BAR; PG8_WAIT_L(0); PG8_MMA(0, 1, At, B1); PG8_BAR;
            PG8_LDA(At, 0, 1); PG8_STAGE(PG8_SA(0, 0), a2, voffA);
            PG8_BAR; PG8_WAIT_L(0); PG8_MMA(1, 0, At, B0); PG8_BAR; PG8_SCHED;
            PG8_STAGE(PG8_SB(0, 1), b2 + hstep, voffB);
            PG8_WAIT_V(6); PG8_BAR; PG8_MMA(1, 1, At, B1); PG8_BAR;
            PG8_LDB(B0, 1, 0); PG8_SCHED; PG8_LDA(At, 1, 0); PG8_STAGE(PG8_SA(0, 1), a2 + hstep, voffA);
            PG8_WAIT_L(8); PG8_BAR; PG8_WAIT_L(0); PG8_MMA(0, 0, At, B0); PG8_BAR; PG8_SCHED;
            PG8_LDB(B1, 1, 1); PG8_STAGE(PG8_SB(1, 0), b3, voffB);
            PG8_BAR; PG8_WAIT_L(0); PG8_MMA(0, 1, At, B1); PG8_BAR;
            PG8_LDA(At, 1, 1); PG8_STAGE(PG8_SA(1, 0), a3, voffA);
            PG8_BAR; PG8_WAIT_L(0); PG8_MMA(1, 0, At, B0); PG8_BAR; PG8_SCHED;
            PG8_STAGE(PG8_SB(1, 1), b3 + hstep, voffB);
            PG8_WAIT_V(6); PG8_BAR; PG8_MMA(1, 1, At, B1); PG8_BAR;
            }
        }
        if constexpr (ALIGN_EPI) { if (wr == 0) PG8_BAR; }
        if constexpr (!Epi::AFTER_DRAIN) { E(acc, cur, wr, wc, fr, fq); S.done(cur); }
        if (!has_next) break;
#pragma unroll
        for (int a = 0; a < 2; ++a)
#pragma unroll
            for (int b = 0; b < 2; ++b)
#pragma unroll
                for (int m = 0; m < 4; ++m)
#pragma unroll
                    for (int n = 0; n < 2; ++n) acc[a][b][m][n] = (f32x4){0.f, 0.f, 0.f, 0.f};
        cur = nxt; cA = nA; cB = nB; ++ui;
        if constexpr (ALIGN_EPI) { if (wr == 1) PG8_BAR; }
    }
    PG8_WAIT_V(0);
    if constexpr (!ALIGN_EPI) { if (wr == 0) PG8_BAR; }
    PG8_BAR;
#undef PG8_SA
#undef PG8_SB
#undef PG8_STAGE
#undef PG8_LDA
#undef PG8_LDB
#undef PG8_MMA
#undef PG8_WAIT_V
#undef PG8_WAIT_L
#undef PG8_BAR
#undef PG8_SCHED
}
}

template <int MTN, int UNR, class Epi>
__device__ __forceinline__ void skinny_unit(LAS unsigned char* lds, const bf16_t* A, int lda, const bf16_t* Bt, int K, const Epi& E, const int tid) {
    const int wid = __builtin_amdgcn_readfirstlane(tid >> 6), lane = tid & 63, fr = lane & 15, fq = lane >> 4;
    const int kw = K / 8, k0 = wid * kw;
    f32x4 acc[MTN];
#pragma unroll
    for (int m = 0; m < MTN; ++m) acc[m] = (f32x4){0.f, 0.f, 0.f, 0.f};
    const bf16_t* ap = A + (size_t)fr * lda + k0 + fq * 8;
    const bf16_t* bp = Bt + (size_t)fr * K + k0 + fq * 8;
    for (int ks = 0; ks < kw; ks += 32 * UNR) {
        bf16x8 b[UNR], a[UNR][MTN];
#pragma unroll
        for (int u = 0; u < UNR; ++u) { b[u] = *(const bf16x8*)(bp + ks + u * 32);
#pragma unroll
            for (int m = 0; m < MTN; ++m) a[u][m] = *(const bf16x8*)(ap + (size_t)(m * 16) * lda + ks + u * 32); }
#pragma unroll
        for (int u = 0; u < UNR; ++u)
#pragma unroll
            for (int m = 0; m < MTN; ++m) acc[m] = __builtin_amdgcn_mfma_f32_16x16x32_bf16(a[u][m], b[u], acc[m], 0, 0, 0);
    }
    constexpr int ROWS = MTN * 16;
    LAS float* part = (LAS float*)lds;
#pragma unroll
    for (int m = 0; m < MTN; ++m)
#pragma unroll
        for (int j = 0; j < 4; ++j) part[(wid * ROWS + m * 16 + fq * 4 + j) * 16 + fr] = acc[m][j];
    __syncthreads();
    if (tid < ROWS * 4) {
        const int row = tid >> 2, c4 = (tid & 3) * 4;
        f32x4 s = (f32x4){0.f, 0.f, 0.f, 0.f};
#pragma unroll
        for (int w = 0; w < 8; ++w) s = s + *(const LAS f32x4*)(part + (w * ROWS + row) * 16 + c4);
        E(row, c4, s, tid);
    }
    __syncthreads();
}
template <int NS> __device__ __forceinline__ float sk_rstd(const float* base, int row, int tid) {
    const f32x4* p = (const f32x4*)(base + (size_t)row * NS + (tid & 3) * (NS / 4)); float s = 0.f;
#pragma unroll
    for (int i = 0; i < NS / 16; ++i) { const f32x4 v = p[i]; s += (v[0] + v[1]) + (v[2] + v[3]); }
    s += __shfl_xor(s, 1); s += __shfl_xor(s, 2);
    return rsqrtf(s * (1.0f / D) + EPS);
}
template <int NS> struct SkAlow { float* O; const float* rowss; __device__ __forceinline__ void operator()(int row, int c4, f32x4 v, int tid) const {
    const float rs = sk_rstd<NS>(rowss, row, tid); *(f32x4*)(O + (size_t)row * 16 + c4) = v * rs; } };
template <int ACT> struct SkScaleBf16 { bf16_t* O; int ldc; const float* rowss; __device__ __forceinline__ void operator()(int row, int c4, f32x4 v, int tid) const {
    const float rs = sk_rstd<64>(rowss, row, tid); v = v * rs;
    if (ACT == 1) {
#pragma unroll
        for (int e = 0; e < 4; ++e) { const float a = fmaxf(v[e], 0.f); v[e] = a * a; } }
    u32x2 w; w.x = cvtpk(v[0], v[1]); w.y = cvtpk(v[2], v[3]); *(u32x2*)(O + (size_t)row * ldc + c4) = w; } };
struct SkRes { bf16_t* XB; float* ssout; int slot; __device__ __forceinline__ void operator()(int row, int c4, f32x4 v, int tid) const {
    const u32x2 xo = *(const u32x2*)(XB + (size_t)row * D + c4);
    u32x2 w; w.x = cvtpk(bflo(xo.x) + v[0], bfhi(xo.x) + v[1]); w.y = cvtpk(bflo(xo.y) + v[2], bfhi(xo.y) + v[3]); *(u32x2*)(XB + (size_t)row * D + c4) = w;
    float ss = (bflo(w.x) * bflo(w.x) + bfhi(w.x) * bfhi(w.x)) + (bflo(w.y) * bflo(w.y) + bfhi(w.y) * bfhi(w.y)); ss += __shfl_xor(ss, 1); ss += __shfl_xor(ss, 2);
    if ((tid & 3) == 0) ssout[(size_t)row * 64 + slot] = ss; } };

#define XB_TMO      128
#define XB_XCNT(j)  (256  + 64 * (j))
#define XB_XSUB(j)  (1280 + 64 * (j))
#define XB_XGEN(j)  (2304 + 64 * (j))
#define XB_TOP      3328
#define XB_TOPGEN   3392
#define XCD_BAR_WORDS 3456
#define XB_SPIN_CAP (1u << 18)
__device__ __forceinline__ unsigned xb_ld(unsigned* p)              { return __hip_atomic_load(p, __ATOMIC_RELAXED, __HIP_MEMORY_SCOPE_AGENT); }
__device__ __forceinline__ unsigned xb_add(unsigned* p, unsigned v) { return __hip_atomic_fetch_add(p, v, __ATOMIC_RELAXED, __HIP_MEMORY_SCOPE_AGENT); }
__device__ __forceinline__ unsigned xb_xcc_id() { return (unsigned)__builtin_amdgcn_s_getreg((3 << 11) | 20) & 0xFu; }
#define XB_SPIN(cond, bar) do { unsigned _sp = 0; while (cond) { __builtin_amdgcn_s_sleep(1); \
    if ((++_sp & 255u) == 0u) { if (xb_ld(&(bar)[XB_TMO])) break; if (_sp > XB_SPIN_CAP) { atomicAdd(&(bar)[XB_TMO], 1u); break; } } } } while (0)
struct XcdBarrier { unsigned* bar; unsigned x; volatile LAS unsigned* st; };
__device__ __forceinline__ XcdBarrier xcd_barrier_post(unsigned* bar, volatile LAS unsigned* st) {
    XcdBarrier b; b.bar = bar; b.x = xb_xcc_id(); b.st = st;
    if (threadIdx.x == 0) (void)xb_add(&bar[XB_XCNT(b.x)], 1u);
    return b;
}
__device__ __forceinline__ void xcd_barrier_complete(unsigned* bar, unsigned x, unsigned& nloc, unsigned& nx) {
    const unsigned G = gridDim.x * gridDim.y * gridDim.z;
    unsigned sum, cnt, mine, sp = 0u;
    for (;;) {
        sum = 0u; cnt = 0u; mine = 0u;
#pragma unroll
        for (unsigned j = 0; j < 16; ++j) { const unsigned c = xb_ld(&bar[XB_XCNT(j)]); sum += c; cnt += (c > 0u) ? 1u : 0u; mine = (j == x) ? c : mine; }
        if (sum == G) break;
        __builtin_amdgcn_s_sleep(1);
        if ((++sp & 255u) == 0u) { if (xb_ld(&bar[XB_TMO])) break; if (sp > XB_SPIN_CAP) { atomicAdd(&bar[XB_TMO], 1u); break; } }
    }
    nloc = mine > 0u ? mine : 1u; nx = cnt > 0u ? cnt : 1u;
}
__device__ __forceinline__ void xcd_barrier(const XcdBarrier& b) {
    asm volatile("s_waitcnt vmcnt(0)" ::: "memory");
    __syncthreads();
    if (threadIdx.x == 0) {
        unsigned* bar = b.bar;
        __builtin_amdgcn_s_waitcnt(0);
        unsigned nloc = b.st[0], nx = b.st[1];
        if (nloc == 0u) { xcd_barrier_complete(bar, b.x, nloc, nx); b.st[0] = nloc; b.st[1] = nx; }
        const unsigned old = xb_add(&bar[XB_XSUB(b.x)], 1u);
        const unsigned gen = old / nloc;
        if (old + 1u == (gen + 1u) * nloc) {
            __builtin_amdgcn_fence(__ATOMIC_RELEASE, "agent");
            asm volatile("s_waitcnt vmcnt(0)" ::: "memory");
            const unsigned og = xb_add(&bar[XB_TOP], 1u);
            const unsigned tg = og / nx;
            if (og + 1u == (tg + 1u) * nx) xb_add(&bar[XB_TOPGEN], 1u);
            else XB_SPIN(xb_ld(&bar[XB_TOPGEN]) == tg, bar);
            __builtin_amdgcn_fence(__ATOMIC_ACQUIRE, "");
            xb_add(&bar[XB_XGEN(b.x)], 1u);
            asm volatile("s_waitcnt vmcnt(0)" ::: "memory");
        } else {
            XB_SPIN(xb_ld(&bar[XB_XGEN(b.x)]) == gen, bar);
            __builtin_amdgcn_fence(__ATOMIC_ACQUIRE, "");
            asm volatile("s_waitcnt vmcnt(0)" ::: "memory");
        }
    }
    __syncthreads();
}

struct Args { const float* in[16]; float* out; unsigned char* ws; int ph_lo, ph_hi, coop, pad; };
struct Frame {
    LAS unsigned char* lds; int tid, lane, wave, G, bid;
    const float *x_prompt, *x_sample, *state_gla, *state_pool, *norm1_g, *w_in, *w_gate, *b_gate, *gla_norm_g, *pool_w, *pool_scale, *w_out, *norm2_g, *w_up, *w_down, *final_g;
    float* out; unsigned char* ws;
    float *rsp, *rss, *alow, *dec, *kvt; bf16_t *xb, *z, *mix, *hid, *st, *qt, *kt, *vt;
};
__device__ __forceinline__ bf16_t* wptr(const Frame& F, int l, size_t off) { return (bf16_t*)(F.ws + WS_W + (size_t)l * W_STRIDE + off); }

struct TItem { const float* W; bf16_t* WT; const float* kscale; int ldw, K, k0, nsrc0, ndst0, nvalid; };
struct TRegs { f32x4 v[8]; float ks[8]; };
__device__ __forceinline__ void titem_decode(const Frame& F, int it, TItem& T) {
    constexpr int I_IN = 16 * 65, I_OUT = 16 * 32, I_UP = 16 * 128, I_DOWN = 64 * 32, I_POOL = 32, I_LAYER = I_IN + I_OUT + I_UP + I_DOWN + I_POOL;
    const int l = it / I_LAYER; int r = it % I_LAYER;
    if (r < I_IN) { const int kb = r / 65, nb = r % 65, nd = nb * 32;
        T = TItem{F.w_in + (size_t)l * D * INW, wptr(F, l, W_IN), F.norm1_g + l * D, INW, D, kb * 64, nd < 1536 ? nd : (nd < 2048 ? nd + 16 : 1536), nd, nd < 2048 ? 32 : 16}; return; } r -= I_IN;
    if (r < I_OUT) { const int kb = r / 32, nb = r % 32; T = TItem{F.w_out + (size_t)l * D * D, wptr(F, l, W_OUT), nullptr, D, D, kb * 64, nb * 32, nb * 32, 32}; return; } r -= I_OUT;
    if (r < I_UP) { const int kb = r / 128, nb = r % 128; T = TItem{F.w_up + (size_t)l * D * FF, wptr(F, l, W_UP), F.norm2_g + l * D, FF, D, kb * 64, nb * 32, nb * 32, 32}; return; } r -= I_UP;
    if (r < I_DOWN) { const int kb = r / 32, nb = r % 32; T = TItem{F.w_down + (size_t)l * FF * D, wptr(F, l, W_DOWN), nullptr, D, FF, kb * 64, nb * 32, nb * 32, 32}; return; } r -= I_DOWN;
    { const int g = r / 8, kb = (r % 8) / 4, nb = r % 4; T = TItem{F.pool_w + ((size_t)l * 4 + g) * 128 * 128, wptr(F, l, W_POOL) + g * 16384, nullptr, 128, 128, kb * 64, nb * 32, nb * 32, 32}; }
}
__device__ __forceinline__ void titem_load(const TItem& T, TRegs& R, int lane) {
    const int c4 = (lane & 7) * 4, kr = lane >> 3;
#pragma unroll
    for (int i = 0; i < 8; ++i) { const int kk = 8 * i + kr; R.v[i] = (c4 < T.nvalid) ? *(const f32x4*)(T.W + (size_t)(T.k0 + kk) * T.ldw + T.nsrc0 + c4) : (f32x4){0.f, 0.f, 0.f, 0.f}; R.ks[i] = T.kscale ? T.kscale[T.k0 + kk] : 1.0f; }
}
__device__ __forceinline__ void titem_store(const TItem& T, const TRegs& R, LAS float* scr, int lane) {
    const int c4 = (lane & 7) * 4, kr = lane >> 3;
#pragma unroll
    for (int i = 0; i < 8; ++i) { const int kk = 8 * i + kr;
#pragma unroll
        for (int e = 0; e < 4; ++e) scr[kk * 33 + c4 + e] = R.v[i][e] * R.ks[i]; }
    LDS_WAIT(); asm volatile("" ::: "memory");
    const int c8 = lane & 7;
#pragma unroll
    for (int j = 0; j < 4; ++j) { const int n = (lane >> 3) + 8 * j; const LAS float* s = scr + (8 * c8) * 33 + n;
        u32x4 o; o.x = cvtpk(s[0 * 33], s[1 * 33]); o.y = cvtpk(s[2 * 33], s[3 * 33]); o.z = cvtpk(s[4 * 33], s[5 * 33]); o.w = cvtpk(s[6 * 33], s[7 * 33]);
        if (n < T.nvalid) *(u32x4*)(T.WT + (size_t)(T.ndst0 + n) * T.K + T.k0 + 8 * c8) = o; }
    LDS_WAIT(); asm volatile("" ::: "memory");
}
__device__ __forceinline__ void p0_prologue(Frame& F) {
    LAS float* scr = (LAS float*)(F.lds + F.wave * 8704);
    const int gw = F.bid * 8 + F.wave, NGW = F.G * 8;
    constexpr int NITEMS = DEPTH * (16 * 65 + 16 * 32 + 16 * 128 + 64 * 32 + 32);
    {
        TItem T0, T1; TRegs R0, R1;
        if (gw < NITEMS) { titem_decode(F, gw, T0); titem_load(T0, R0, F.lane); }
        for (int it = gw; it < NITEMS; it += NGW) {
            const bool more = it + NGW < NITEMS;
            if (more) { titem_decode(F, it + NGW, T1); titem_load(T1, R1, F.lane); }
            titem_store(T0, R0, scr, F.lane);
            if (more) { T0 = T1; R0 = R1; }
        }
    }
    f32x4 v0[4], v1[4];
    if (gw < MT) { const float* src = gw < MP ? F.x_prompt + (size_t)gw * D : F.x_sample + (size_t)(gw - MP) * D;
#pragma unroll
        for (int j = 0; j < 4; ++j) v0[j] = ((const f32x4*)src + F.lane)[64 * j]; }
    for (int m = gw; m < MT; m += NGW) {
        const int mn = m + NGW;
        if (mn < MT) { const float* src = mn < MP ? F.x_prompt + (size_t)mn * D : F.x_sample + (size_t)(mn - MP) * D;
#pragma unroll
            for (int j = 0; j < 4; ++j) v1[j] = ((const f32x4*)src + F.lane)[64 * j]; }
        u32x2* bo = (u32x2*)(F.xb + (size_t)m * D) + F.lane;
        float s = 0.f;
#pragma unroll
        for (int j = 0; j < 4; ++j) { const f32x4 v = v0[j]; u32x2 w; w.x = cvtpk(v[0], v[1]); w.y = cvtpk(v[2], v[3]); bo[64 * j] = w; s += (v[0] * v[0] + v[1] * v[1]) + (v[2] * v[2] + v[3] * v[3]); }
        s = wave_sum(s);
        if (m < MP) { if (F.lane < 16) F.rsp[(size_t)m * 16 + F.lane] = F.lane == 0 ? s : 0.f; }
        else F.rss[(size_t)(m - MP) * 64 + F.lane] = F.lane == 0 ? s : 0.f;
        if (mn < MT) {
#pragma unroll
            for (int j = 0; j < 4; ++j) v0[j] = v1[j]; }
    }
}

constexpr int L_AL = 0, L_B = 4096, L_TOT = 20736, L_BL = 22784, L_QT = 23040, L_KT = 32256, L_VT = 41472, L_ATT = 59904, L_SS = 69120;
__device__ __forceinline__ float logsig(float x) { return fminf(x, 0.f) - __logf(1.f + __expf(-fabsf(x))); }
__device__ __forceinline__ float rdlane(float v, int lane) { return __int_as_float(__builtin_amdgcn_readlane(__float_as_int(v), lane)); }
struct KvC { float w[16]; float bj; };
struct KvU { f32x4 alv; bf16_t qv[8], kv[8]; u32x4 vv[2]; };
__device__ __forceinline__ void gla_kv_loadc(const Frame& F, int l, int h, KvC& C) {
    const int j = F.tid & 63; const float* wg = F.w_gate + (size_t)l * 16 * 256 + h * 64 + j;
#pragma unroll
    for (int r = 0; r < 16; ++r) C.w[r] = wg[r * 256];
    C.bj = F.b_gate[l * 256 + h * 64 + j];
}
__device__ __forceinline__ void gla_kv_load(const Frame& F, int unit, KvU& U) {
    const int bh = unit >> 5, n = unit & 31, b = bh >> 2, h = bh & 3, row0 = b * SEQ + n * 64, tid = F.tid, j = tid & 63, cgp = F.wave;
    const bf16_t* zrow0 = F.z + (size_t)row0 * ZLD;
    const float* al = F.alow + (size_t)(row0 + cgp * 8) * 16;
    U.alv = (f32x4){0.f, 0.f, 0.f, 0.f}; if (F.lane < 32) U.alv = *(const f32x4*)(al + F.lane * 4);
#pragma unroll
    for (int i = 0; i < 8; ++i) { const bf16_t* zr = zrow0 + (size_t)(cgp * 8 + i) * ZLD + h * 64 + j; U.qv[i] = zr[ZQ]; U.kv[i] = zr[ZK]; }
#pragma unroll
    for (int pass = 0; pass < 2; ++pass) U.vv[pass] = *(const u32x4*)(zrow0 + (size_t)((tid >> 4) + pass * 32) * ZLD + ZV + h * 128 + (tid & 15) * 8);
}
__device__ __forceinline__ void gla_kv_unit(const Frame& F, int l, int unit, const KvC& C, const KvU& U) {
    const int tid = F.tid;
    LAS float* sTot = (LAS float*)(F.lds + L_TOT);
    LAS bf16_t* sQt = (LAS bf16_t*)(F.lds + L_QT); LAS bf16_t* sKt = (LAS bf16_t*)(F.lds + L_KT); LAS bf16_t* sKeT = (LAS bf16_t*)(F.lds + L_ATT); LAS bf16_t* sVT = (LAS bf16_t*)(F.lds + L_VT);
    const int j = tid & 63, cgp = F.wave;
    const f32x4 alv = U.alv; const float bj = C.bj;
    float loc[8]; float run = 0.f;
#pragma unroll
    for (int i = 0; i < 8; ++i) { float ga = bj;
#pragma unroll
        for (int r = 0; r < 16; ++r) ga += rdlane(alv[r & 3], i * 4 + (r >> 2)) * C.w[r];
        run += logsig(ga) * (1.0f / 16.0f); loc[i] = run; }
    sTot[cgp * 64 + j] = run;
#pragma unroll
    for (int pass = 0; pass < 2; ++pass) { const int vg = tid & 15, sidx = (tid >> 4) + pass * 32;
#pragma unroll
        for (int i = 0; i < 4; ++i) { sVT[(vg * 8 + 2 * i) * 72 + sidx] = (bf16_t)(U.vv[pass][i] & 0xffffu); sVT[(vg * 8 + 2 * i + 1) * 72 + sidx] = (bf16_t)(U.vv[pass][i] >> 16); } }
    __syncthreads();
    float off = 0.f, tot = 0.f;
#pragma unroll
    for (int g = 0; g < 8; ++g) { const float tv = sTot[g * 64 + j]; off += (g < cgp) ? tv : 0.f; tot += tv; }
    u32x4 kep;
#pragma unroll
    for (int i = 0; i < 8; i += 2) {
        const float b0 = off + loc[i], b1 = off + loc[i + 1];
        const float q0 = bf2f(U.qv[i]), q1 = bf2f(U.qv[i + 1]), k0 = bf2f(U.kv[i]), k1 = bf2f(U.kv[i + 1]);
        sQt[(cgp * 8 + i) * 72 + j] = f2bf(q0 * __expf(b0) * 0.125f); sQt[(cgp * 8 + i + 1) * 72 + j] = f2bf(q1 * __expf(b1) * 0.125f);
        sKt[(cgp * 8 + i) * 72 + j] = f2bf(k0 * __expf(-b0)); sKt[(cgp * 8 + i + 1) * 72 + j] = f2bf(k1 * __expf(-b1));
        kep[i >> 1] = cvtpk(k0 * __expf(tot - b0), k1 * __expf(tot - b1)); }
    *(LAS u32x4*)(sKeT + j * 72 + cgp * 8) = kep;
    if (cgp == 0) F.dec[unit * 64 + j] = __expf(tot);
    __syncthreads();
    const int wv = F.wave, fr = F.lane & 15, fq = F.lane >> 4;
    f32x4 acc[4];
#pragma unroll
    for (int nt = 0; nt < 4; ++nt) acc[nt] = (f32x4){0.f, 0.f, 0.f, 0.f};
#pragma unroll
    for (int ks = 0; ks < 2; ++ks) { const bf16x8 a = *(const LAS bf16x8*)(sVT + (wv * 16 + fr) * 72 + ks * 32 + fq * 8);
#pragma unroll
        for (int nt = 0; nt < 4; ++nt) { const bf16x8 bb = *(const LAS bf16x8*)(sKeT + (nt * 16 + fr) * 72 + ks * 32 + fq * 8); acc[nt] = __builtin_amdgcn_mfma_f32_16x16x32_bf16(a, bb, acc[nt], 0, 0, 0); } }
    { const int sr = tid >> 3, kg = tid & 7;
      *(u32x4*)(F.qt + (size_t)unit * 4096 + sr * 64 + kg * 8) = *(const LAS u32x4*)(sQt + sr * 72 + kg * 8);
      *(u32x4*)(F.kt + (size_t)unit * 4096 + sr * 64 + kg * 8) = *(const LAS u32x4*)(sKt + sr * 72 + kg * 8);
#pragma unroll
      for (int p = 0; p < 2; ++p) { const int id = tid + 512 * p, vc = id >> 3, ch = id & 7; *(u32x4*)(F.vt + (size_t)unit * 8192 + vc * 64 + ch * 8) = *(const LAS u32x4*)(sVT + vc * 72 + ch * 8); } }
    float* kvt = F.kvt + (size_t)unit * 8192;
#pragma unroll
    for (int nt = 0; nt < 4; ++nt)
#pragma unroll
        for (int jj = 0; jj < 4; ++jj) kvt[(wv * 16 + fq * 4 + jj) * 64 + nt * 16 + fr] = acc[nt][jj];
    __syncthreads();
}
struct OutU { u32x4 q16, k16, v16[2]; bf16x8 bs[4][2]; bf16_t gzr[4][4]; };
__device__ __forceinline__ void gla_out_load(const Frame& F, int unit, OutU& U) {
    const int bh = unit >> 5, n = unit & 31, b = bh >> 2, h = bh & 3, row0 = b * SEQ + n * 64;
    const bf16_t* zrow0 = F.z + (size_t)row0 * ZLD;
    const int w = F.wave, fr = F.lane & 15, fq = F.lane >> 4, mt = w >> 1, nt4 = (w & 1) * 4, sr = F.tid >> 3, kg = F.tid & 7;
    U.q16 = *(const u32x4*)(F.qt + (size_t)unit * 4096 + sr * 64 + kg * 8); U.k16 = *(const u32x4*)(F.kt + (size_t)unit * 4096 + sr * 64 + kg * 8);
#pragma unroll
    for (int p = 0; p < 2; ++p) { const int id = F.tid + 512 * p; U.v16[p] = *(const u32x4*)(F.vt + (size_t)unit * 8192 + (id >> 3) * 64 + (id & 7) * 8); }
    const bf16_t* stg = F.st + (size_t)unit * 8192;
#pragma unroll
    for (int q = 0; q < 4; ++q)
#pragma unroll
        for (int ks = 0; ks < 2; ++ks) U.bs[q][ks] = *(const bf16x8*)(stg + ((nt4 + q) * 16 + fr) * 64 + ks * 32 + fq * 8);
#pragma unroll
    for (int j = 0; j < 4; ++j)
#pragma unroll
        for (int q = 0; q < 4; ++q) U.gzr[j][q] = zrow0[(size_t)(mt * 16 + fq * 4 + j) * ZLD + ZG + h * 128 + (nt4 + q) * 16 + fr];
}
__device__ __forceinline__ void gla_out_unit_v3(const Frame& F, int l, int unit, const OutU& U, const float (&gnv)[4]) {
    const int bh = unit >> 5, n = unit & 31, b = bh >> 2, h = bh & 3, row0 = b * SEQ + n * 64;
    LAS float* sSS = (LAS float*)(F.lds + L_SS);
    LAS bf16_t* sQt = (LAS bf16_t*)(F.lds + L_QT); LAS bf16_t* sKt = (LAS bf16_t*)(F.lds + L_KT); LAS bf16_t* sVT = (LAS bf16_t*)(F.lds + L_VT); LAS bf16_t* sAtt = (LAS bf16_t*)(F.lds + L_ATT);
    const int w = F.wave, fr = F.lane & 15, fq = F.lane >> 4, mt = w >> 1, nt4 = (w & 1) * 4;
    { const int sr = F.tid >> 3, kg = F.tid & 7;
      *(LAS u32x4*)(sQt + sr * 72 + kg * 8) = U.q16; *(LAS u32x4*)(sKt + sr * 72 + kg * 8) = U.k16;
#pragma unroll
      for (int p = 0; p < 2; ++p) { const int id = F.tid + 512 * p; *(LAS u32x4*)(sVT + (id >> 3) * 72 + (id & 7) * 8) = U.v16[p]; } }
    __syncthreads();
#pragma unroll
    for (int q = 0; q < 2; ++q) { const int nt = (w & 1) * 2 + q;
        f32x4 acc = (f32x4){0.f, 0.f, 0.f, 0.f};
        if (nt <= mt) {
#pragma unroll
            for (int ks = 0; ks < 2; ++ks) { const bf16x8 a = *(const LAS bf16x8*)(sQt + (mt * 16 + fr) * 72 + ks * 32 + fq * 8); const bf16x8 bb = *(const LAS bf16x8*)(sKt + (nt * 16 + fr) * 72 + ks * 32 + fq * 8);
                acc = __builtin_amdgcn_mfma_f32_16x16x32_bf16(a, bb, acc, 0, 0, 0); } }
#pragma unroll
        for (int j = 0; j < 4; ++j) { const int c = mt * 16 + fq * 4 + j, s = nt * 16 + fr; sAtt[c * 72 + s] = f2bf(s <= c ? acc[j] : 0.f); } }
    __syncthreads();
    f32x4 o[4];
#pragma unroll
    for (int q = 0; q < 4; ++q) o[q] = (f32x4){0.f, 0.f, 0.f, 0.f};
#pragma unroll
    for (int ks = 0; ks < 2; ++ks) {
        const bf16x8 a1 = *(const LAS bf16x8*)(sAtt + (mt * 16 + fr) * 72 + ks * 32 + fq * 8); const bf16x8 a2 = *(const LAS bf16x8*)(sQt + (mt * 16 + fr) * 72 + ks * 32 + fq * 8);
#pragma unroll
        for (int q = 0; q < 4; ++q) { const int nt = nt4 + q;
            const bf16x8 bv = *(const LAS bf16x8*)(sVT + (nt * 16 + fr) * 72 + ks * 32 + fq * 8);
            o[q] = __builtin_amdgcn_mfma_f32_16x16x32_bf16(a1, bv, o[q], 0, 0, 0); o[q] = __builtin_amdgcn_mfma_f32_16x16x32_bf16(a2, U.bs[q][ks], o[q], 0, 0, 0); } }
    float p[4];
#pragma unroll
    for (int j = 0; j < 4; ++j) { float s = 0.f;
#pragma unroll
        for (int q = 0; q < 4; ++q) s += o[q][j] * o[q][j];
        s += __shfl_xor(s, 1); s += __shfl_xor(s, 2); s += __shfl_xor(s, 4); s += __shfl_xor(s, 8); p[j] = s; }
    if (fr == 0) {
#pragma unroll
        for (int j = 0; j < 4; ++j) sSS[(w & 1) * 64 + mt * 16 + fq * 4 + j] = p[j]; }
    __syncthreads();
#pragma unroll
    for (int j = 0; j < 4; ++j) { const int c = mt * 16 + fq * 4 + j; const float rs = rsqrtf((sSS[c] + sSS[64 + c]) * (1.0f / 128.0f) + EPS);
#pragma unroll
        for (int q = 0; q < 4; ++q) { const int vcol = (nt4 + q) * 16 + fr; const float gz = bf2f(U.gzr[j][q]);
            const float val = o[q][j] * rs * gnv[q] * (gz / (1.f + __expf(-gz)));
            F.mix[(size_t)(row0 + c) * D + h * 128 + vcol] = f2bf(val); } }
    __syncthreads();
}
__device__ __forceinline__ void gla_scan_elem(const Frame& F, int l, int e) {
    const int bh = e >> 12, idx = (e & 4095) * 2, k = idx & 63, vcol = idx >> 6;
    const float* kv = F.kvt + (size_t)bh * 32 * 8192 + idx; const float* dc = F.dec + bh * 32 * 64 + k; bf16_t* st = F.st + (size_t)bh * 32 * 8192 + idx;
    f32x2 S = (f32x2){0.f, 0.f};
#pragma unroll 8
    for (int n = 0; n < 32; ++n) { *(unsigned*)(st + (size_t)n * 8192) = cvtpk(S[0], S[1]);
        const f32x2 d = *(const f32x2*)(dc + n * 64), x = *(const f32x2*)(kv + (size_t)n * 8192); S = d * S + x; }
    float* o = F.out + O_GLAP + ((size_t)l * 32 + bh) * 8192 + k * 128 + vcol;
    o[0] = S[0]; o[128] = S[1];
}
__device__ __forceinline__ void gla_scan(const Frame& F, int l) {
    if (F.G == 256) { const int b = F.bid & 7, j = F.bid >> 3; gla_scan_elem(F, l, (b * 4 + (j >> 3)) * 4096 + (j & 7) * 512 + F.tid); }
    else for (int e = F.bid * 512 + F.tid; e < 32 * 4096; e += F.G * 512) gla_scan_elem(F, l, e);
}
__device__ __forceinline__ void gla_decode_unit(const Frame& F, int l, int unit) {
    const int s = unit >> 2, h = unit & 3, row = MP + s, tid = F.tid;
    const bf16_t* zrow = F.z + (size_t)row * ZLD;
    LAS float* sA = (LAS float*)(F.lds); LAS float* sQ = sA + 64; LAS float* sK = sA + 128; LAS float* sO = sA + 192; LAS float* sRed = sA + 192 + 512;
    const int v = tid & 127, kg = tid >> 7;
    const size_t soff = (((size_t)l * 128 + s) * 4 + h) * 8192;
    const float* S0 = F.state_gla + soff; float* Sn = F.out + O_GLAS + soff;
    float s0r[16];
#pragma unroll
    for (int i = 0; i < 16; ++i) s0r[i] = S0[(kg * 16 + i) * 128 + v];
    const float vv = bf2f(zrow[ZV + h * 128 + v]); const float gzv = bf2f(zrow[ZG + h * 128 + v]);
    if (tid < 64) { const int j = tid; const float* wg = F.w_gate + (size_t)l * 16 * 256 + h * 64 + j; float ga = F.b_gate[l * 256 + h * 64 + j];
#pragma unroll
        for (int r = 0; r < 16; ++r) ga += F.alow[(size_t)row * 16 + r] * wg[r * 256];
        sA[j] = __expf(logsig(ga) * (1.0f / 16.0f)); sQ[j] = bf2f(zrow[ZQ + h * 64 + j]); sK[j] = bf2f(zrow[ZK + h * 64 + j]); }
    __syncthreads();
    float po = 0.f;
#pragma unroll 16
    for (int i = 0; i < 16; ++i) { const int k = kg * 16 + i; const float sn = sA[k] * s0r[i] + sK[k] * vv; Sn[k * 128 + v] = sn; po += sQ[k] * sn; }
    sO[kg * 128 + v] = po;
    __syncthreads();
    float o = 0.f;
    if (tid < 128) { o = 0.125f * ((sO[v] + sO[128 + v]) + (sO[256 + v] + sO[384 + v])); const float sq = wave_sum(o * o); if (F.lane == 0) sRed[F.wave] = sq; }
    __syncthreads();
    if (tid < 128) { const float rs = rsqrtf((sRed[0] + sRed[1]) * (1.0f / 128.0f) + EPS); const float gz = gzv;
        F.mix[(size_t)row * D + h * 128 + v] = f2bf(o * rs * F.gla_norm_g[l * 128 + v] * (gz / (1.f + __expf(-gz)))); }
    __syncthreads();
}
constexpr int L_U = 0, L_P = 40448;
struct PoolB { bf16x8 b[4][4]; float sc[4]; };
__device__ __forceinline__ void pool_load_b(const Frame& F, int l, int g, PoolB& P) {
    const int w = F.wave, fr = F.lane & 15, fq = F.lane >> 4, nt4 = (w & 1) * 4;
    const bf16_t* pw = wptr(F, l, W_POOL) + g * 16384;
#pragma unroll
    for (int q = 0; q < 4; ++q) {
#pragma unroll
        for (int ks = 0; ks < 4; ++ks) P.b[q][ks] = *(const bf16x8*)(pw + ((nt4 + q) * 16 + fr) * 128 + ks * 32 + fq * 8);
        P.sc[q] = F.pool_scale[l * 512 + g * 128 + (nt4 + q) * 16 + fr]; }
}
__device__ __forceinline__ void pool_mma_store(const Frame& F, int g, int row0, const PoolB& P) {
    LAS bf16_t* sP = (LAS bf16_t*)(F.lds + L_P);
    const int w = F.wave, fr = F.lane & 15, fq = F.lane >> 4, mt = w >> 1, nt4 = (w & 1) * 4;
    f32x4 acc[4];
#pragma unroll
    for (int q = 0; q < 4; ++q) acc[q] = (f32x4){0.f, 0.f, 0.f, 0.f};
#pragma unroll
    for (int ks = 0; ks < 4; ++ks) { const bf16x8 a = *(const LAS bf16x8*)(sP + (mt * 16 + fr) * 136 + ks * 32 + fq * 8);
#pragma unroll
        for (int q = 0; q < 4; ++q) acc[q] = __builtin_amdgcn_mfma_f32_16x16x32_bf16(a, P.b[q][ks], acc[q], 0, 0, 0); }
#pragma unroll
    for (int q = 0; q < 4; ++q) { const int d = (nt4 + q) * 16 + fr;
#pragma unroll
        for (int j = 0; j < 4; ++j) F.mix[(size_t)(row0 + mt * 16 + fq * 4 + j) * D + 512 + g * 128 + d] = f2bf(acc[q][j] * P.sc[q]); }
}
struct PoolU { u32x4 uv[3]; };
__device__ __forceinline__ void pool_prompt_load(const Frame& F, int unit, PoolU& U) {
    const int g = unit & 3, bn = unit >> 2, n = bn & 31, b = bn >> 5, t0 = n * 64, tid = F.tid, cg8 = tid & 15;
#pragma unroll
    for (int pass = 0; pass < 3; ++pass) { const int i = (tid >> 4) + pass * 32, t = t0 - 15 + i;
        U.uv[pass] = (u32x4){0u, 0u, 0u, 0u}; if (i < 79 && t >= 0) U.uv[pass] = *(const u32x4*)(F.z + (size_t)(b * SEQ + t) * ZLD + ZU + g * 128 + cg8 * 8); }
}
__device__ __forceinline__ void pool_prompt_unit(const Frame& F, int l, int unit, const PoolU& U, const PoolB& PB) {
    const int g = unit & 3, bn = unit >> 2, n = bn & 31, b = bn >> 5, t0 = n * 64, row0 = b * SEQ + t0, tid = F.tid;
    LAS float* sU = (LAS float*)(F.lds + L_U); LAS bf16_t* sP = (LAS bf16_t*)(F.lds + L_P);
    { const int cg8 = tid & 15;
#pragma unroll
      for (int pass = 0; pass < 3; ++pass) { const int i = (tid >> 4) + pass * 32; if (i < 79) {
          { const u32x4 uu = U.uv[pass]; *(LAS f32x4*)(sU + i * 128 + cg8 * 8) = (f32x4){bflo(uu.x), bfhi(uu.x), bflo(uu.y), bfhi(uu.y)}; *(LAS f32x4*)(sU + i * 128 + cg8 * 8 + 4) = (f32x4){bflo(uu.z), bfhi(uu.z), bflo(uu.w), bfhi(uu.w)}; } } } }
    __syncthreads();
    { const int c = tid & 127, tg = tid >> 7, wdw = 2 << g;
      float s = 0.f; const int i0 = tg * 16 + 15;
      for (int d = 1; d < wdw; ++d) s += sU[(i0 - d) * 128 + c];
#pragma unroll 4
      for (int tt = 0; tt < 16; ++tt) { const int i = i0 + tt; const float u = sU[i * 128 + c]; s += u; const int t = t0 + tg * 16 + tt; const float cnt = (float)min(wdw, t + 1);
          sP[(tg * 16 + tt) * 136 + c] = f2bf(s / cnt - u); s -= sU[(i - wdw + 1) * 128 + c]; }
      if (n == 31 && tid < 128) {
#pragma unroll
          for (int j = 0; j < 15; ++j) F.out[O_POOLP + (((size_t)l * 8 + b) * 15 + j) * 512 + g * 128 + c] = sU[(64 + j) * 128 + c]; } }
    __syncthreads();
    pool_mma_store(F, g, row0, PB);
    __syncthreads();
}
__device__ __forceinline__ void pool_sample_unit(const Frame& F, int l, int unit) {
    const int g = unit & 3, sblk = unit >> 2, tid = F.tid, c = tid & 127, sg = tid >> 7, wdw = 2 << g;
    LAS bf16_t* sP = (LAS bf16_t*)(F.lds + L_P);
    const int w = F.wave, fr = F.lane & 15, fq = F.lane >> 4;
    bf16x8 bfr[4];
    { const bf16_t* pw = wptr(F, l, W_POOL) + g * 16384;
#pragma unroll
      for (int ks = 0; ks < 4; ++ks) bfr[ks] = *(const bf16x8*)(pw + (w * 16 + fr) * 128 + ks * 32 + fq * 8); }
    const float sc = F.pool_scale[l * 512 + g * 128 + w * 16 + fr];
    float pv[4][15]; float uv[4];
#pragma unroll
    for (int i = 0; i < 4; ++i) { const int s = sblk * 16 + sg * 4 + i;
        const float* sp = F.state_pool + (((size_t)l * 128 + s) * 15) * 512 + g * 128 + c;
        uv[i] = bf2f(F.z[(size_t)(MP + s) * ZLD + ZU + g * 128 + c]);
#pragma unroll
        for (int j = 0; j < 15; ++j) pv[i][j] = sp[j * 512]; }
#pragma unroll
    for (int i = 0; i < 4; ++i) { const int sl = sg * 4 + i, s = sblk * 16 + sl;
        float* so = F.out + O_POOLS + (((size_t)l * 128 + s) * 15) * 512 + g * 128 + c;
        float sum = uv[i];
#pragma unroll
        for (int j = 0; j < 15; ++j) { if (j >= 16 - wdw) sum += pv[i][j]; if (j >= 1) so[(j - 1) * 512] = pv[i][j]; }
        so[14 * 512] = uv[i];
        sP[sl * 136 + c] = f2bf(sum / (float)wdw - uv[i]); }
    __syncthreads();
    f32x4 acc = (f32x4){0.f, 0.f, 0.f, 0.f};
#pragma unroll
    for (int ks = 0; ks < 4; ++ks) { const bf16x8 a = *(const LAS bf16x8*)(sP + fr * 136 + ks * 32 + fq * 8); acc = __builtin_amdgcn_mfma_f32_16x16x32_bf16(a, bfr[ks], acc, 0, 0, 0); }
#pragma unroll
    for (int j = 0; j < 4; ++j) F.mix[(size_t)(MP + sblk * 16 + fq * 4 + j) * D + 512 + g * 128 + w * 16 + fr] = f2bf(acc[j] * sc);
    __syncthreads();
}

__device__ __forceinline__ int gla_unit_at(int bid, int G, int k) { if (G != 256) return bid + k * G; const int b = bid & 7, j = bid >> 3; return ((b * 4 + (j & 3)) << 5) | ((j >> 2) * 4 + k); }
__device__ __forceinline__ int pool_unit_at(int bid, int G, int k) { if (G != 256) return bid + k * G; const int b = bid & 7, j = bid >> 3; return ((b * 32 + (j >> 2) * 4 + k) << 2) | (j & 3); }
__device__ __forceinline__ int units_of(int bid, int G) { return G == 256 ? 4 : (1024 - bid + G - 1) / G; }

__global__ void __launch_bounds__(512, 2) hymba_fwd(Args args) {
    extern __shared__ __attribute__((aligned(16))) unsigned char lds_raw[];
    cg::grid_group grid = cg::this_grid();
    typedef const __attribute__((address_space(4))) Args* KArgs;
    const KArgs ap0 = (KArgs)__builtin_amdgcn_kernarg_segment_ptr();
    const int ph_lo = ap0->ph_lo, ph_hi = ap0->ph_hi, coop = ap0->coop;
    for (int u = threadIdx.x; u < (LDS_BYTES - 131072) / 4; u += 512) ((LAS unsigned*)((LAS unsigned char*)lds_raw + 131072))[u] = 0u;
    __syncthreads();
    if (coop) (void)xcd_barrier_post((unsigned*)(ap0->ws + WS_CTL), (volatile LAS unsigned*)((LAS unsigned char*)lds_raw + MISC_OFF) + 8);
#ifndef PROBE_REP
#define PROBE_REP 0
#endif
    for (int ph = ph_lo; ph < ph_hi; ++ph) {
    const int sub_ = (ph == 0) ? -1 : (ph - 1) % 7; const int nrep = (ph == NPHASE - 1) ? 1 : ((ph == 0) ? ((PROBE_REP & 1) ? 2 : 1) : ((sub_ == 0 && (PROBE_REP & 2)) || (sub_ == 1 && (PROBE_REP & 4)) || (sub_ == 2 && (PROBE_REP & 8)) || (sub_ == 3 && (PROBE_REP & 16)) || (sub_ == 5 && (PROBE_REP & 32))) ? 2 : 1);
    for (int rep_ = 0; rep_ < nrep; ++rep_) {
    int tid_ = threadIdx.x; asm volatile("" : "+v"(tid_));
    KArgs ap = ap0; asm volatile("" : "+s"(ap));
    unsigned char* ws_ = ap->ws; float* out_ = ap->out;
    Frame F;
    F.lds = (LAS unsigned char*)lds_raw; F.tid = tid_; F.lane = F.tid & 63; F.wave = __builtin_amdgcn_readfirstlane(F.tid >> 6); F.G = gridDim.x; F.bid = blockIdx.x;
    F.x_prompt = ap->in[0]; F.x_sample = ap->in[1]; F.state_gla = ap->in[2]; F.state_pool = ap->in[3]; F.norm1_g = ap->in[4]; F.w_in = ap->in[5]; F.w_gate = ap->in[6]; F.b_gate = ap->in[7];
    F.gla_norm_g = ap->in[8]; F.pool_w = ap->in[9]; F.pool_scale = ap->in[10]; F.w_out = ap->in[11]; F.norm2_g = ap->in[12]; F.w_up = ap->in[13]; F.w_down = ap->in[14]; F.final_g = ap->in[15];
    F.out = out_; F.ws = ws_;
    F.rsp = (float*)(F.ws + WS_RSP); F.rss = (float*)(F.ws + WS_RSS); F.alow = (float*)(F.ws + WS_ALOW); F.dec = (float*)(F.ws + WS_DEC); F.kvt = (float*)(F.ws + WS_KVT);
    F.xb = (bf16_t*)(F.ws + WS_XB); F.z = (bf16_t*)(F.ws + WS_Z); F.mix = (bf16_t*)(F.ws + WS_MIX); F.hid = (bf16_t*)(F.ws + WS_HID); F.st = (bf16_t*)(F.ws + WS_ST);
    F.qt = (bf16_t*)(F.ws + WS_QKV); F.kt = F.qt + (size_t)1024 * 4096; F.vt = F.kt + (size_t)1024 * 4096;
        if (ph == 0) {
            p0_prologue(F);
        } else if (ph == NPHASE - 1) {
            const int gw = F.bid * 8 + F.wave, NGW = F.G * 8;
            for (int m = gw; m < MT; m += NGW) { const u32x2* xr = (const u32x2*)(F.xb + (size_t)m * D) + F.lane; f32x4* yo = (f32x4*)(F.out + (size_t)m * D) + F.lane; const f32x4* gr = (const f32x4*)F.final_g + F.lane;
                const float part = m < MP ? (F.lane < 16 ? F.rsp[((size_t)8 * MP + m) * 16 + F.lane] : 0.f) : F.rss[((size_t)8 * 128 + (m - MP)) * 64 + F.lane];
                const float rs = rsqrtf(wave_sum(part) * (1.0f / D) + EPS);
#pragma unroll
                for (int j = 0; j < 4; ++j) { const u32x2 xw = xr[64 * j]; f32x4 v = (f32x4){bflo(xw.x), bfhi(xw.x), bflo(xw.y), bfhi(xw.y)}; v = v * rs * gr[64 * j]; yo[64 * j] = v; } }
        } else {
            const int l = (ph - 1) / 7, sub = (ph - 1) % 7;
            if (sub == 0) {
                const float* ssp = F.rsp + (size_t)(2 * l) * MP * 16; const float* sss = F.rss + (size_t)(2 * l) * 128 * 64;
                { pg8::Gemm g{F.xb, wptr(F, l, W_IN), MP, ZLD, D}; pg8::StaticOrder S; S.init(MP, ZLD, F.G, F.bid);
                  pg8::EpiScaleBf16<0> E{F.z, ZLD, ssp};
                  pg8::gemm_phase<pg8::EpiScaleBf16<0>, pg8::StaticOrder, true, true>(F.lds, g, S, E, F.tid); }
                for (int u = F.bid; u < 129 + 128; u += F.G) {
                    if (u < 128) { SkAlow<16> E{F.alow + (size_t)u * 128 * 16, ssp + (size_t)u * 128 * 16}; skinny_unit<8, 2>(F.lds, F.xb + (size_t)u * 128 * D, D, wptr(F, l, W_IN) + (size_t)2048 * D, D, E, F.tid); }
                    else if (u == 128) { SkAlow<64> E{F.alow + (size_t)u * 128 * 16, sss}; skinny_unit<8, 2>(F.lds, F.xb + (size_t)u * 128 * D, D, wptr(F, l, W_IN) + (size_t)2048 * D, D, E, F.tid); }
                    else { const int j = u - 129; SkScaleBf16<0> E{F.z + (size_t)MP * ZLD + j * 16, ZLD, sss}; skinny_unit<8, 2>(F.lds, F.xb + (size_t)MP * D, D, wptr(F, l, W_IN) + (size_t)j * 16 * D, D, E, F.tid); }
                }
            } else if (sub == 1) {
                { KvC C; KvU U0; const int nu = units_of(F.bid, F.G);
                  const int u0 = gla_unit_at(min(F.bid, 1023), F.G, 0); gla_kv_loadc(F, l, (u0 >> 5) & 3, C); gla_kv_load(F, u0, U0);
                  for (int k = 0; k < nu; ++k) { const int u = gla_unit_at(F.bid, F.G, k); if (F.G != 256) gla_kv_loadc(F, l, (u >> 5) & 3, C);
                      KvU U1; if (k + 1 < nu) gla_kv_load(F, gla_unit_at(F.bid, F.G, k + 1), U1); else U1 = U0;
                      gla_kv_unit(F, l, u, C, U0); U0 = U1; } }
            } else if (sub == 2) {
                { PoolB PB; PoolU U0; const int nu = units_of(F.bid, F.G);
                  const int u0 = pool_unit_at(min(F.bid, 1023), F.G, 0); pool_load_b(F, l, u0 & 3, PB); pool_prompt_load(F, u0, U0);
                  gla_scan(F, l);
                  for (int k = 0; k < nu; ++k) { const int u = pool_unit_at(F.bid, F.G, k); if (F.G != 256) pool_load_b(F, l, u & 3, PB);
                      PoolU U1; if (k + 1 < nu) pool_prompt_load(F, pool_unit_at(F.bid, F.G, k + 1), U1); else U1 = U0;
                      pool_prompt_unit(F, l, u, U0, PB); U0 = U1; } }
                for (int u = 1024 + F.bid; u < 1024 + 32 + 512; u += F.G) {
                    if (u < 1056) pool_sample_unit(F, l, u - 1024); else gla_decode_unit(F, l, u - 1056);
                }
            } else if (sub == 3) {
                { OutU U0; float gnv[4];
#pragma unroll
                  for (int q = 0; q < 4; ++q) gnv[q] = F.gla_norm_g[l * 128 + ((F.wave & 1) * 4 + q) * 16 + (F.lane & 15)];
                  const int nu = units_of(F.bid, F.G); gla_out_load(F, gla_unit_at(min(F.bid, 1023), F.G, 0), U0);
                  for (int k = 0; k < nu; ++k) { const int u = gla_unit_at(F.bid, F.G, k); OutU U1; if (k + 1 < nu) gla_out_load(F, gla_unit_at(F.bid, F.G, k + 1), U1); else U1 = U0;
                      gla_out_unit_v3(F, l, u, U0, gnv); U0 = U1; } }
            } else if (sub == 4) {
                float* ssp = F.rsp + (size_t)(2 * l + 1) * MP * 16; float* sss = F.rss + (size_t)(2 * l + 1) * 128 * 64;
                { pg8::Gemm g{F.mix, wptr(F, l, W_OUT), MP, D, D}; pg8::StaticOrder S; S.init(MP, D, F.G, F.bid);
                  pg8::EpiRes E{F.xb, ssp};
                  pg8::gemm_phase<pg8::EpiRes, pg8::StaticOrder, true, true>(F.lds, g, S, E, F.tid); }
                for (int uu = F.bid; uu < 256; uu += F.G) { const int u = uu & 63, r0 = MP + (uu >> 6) * 32; SkRes E{F.xb + (size_t)r0 * D + u * 16, sss + (size_t)(r0 - MP) * 64, u}; skinny_unit<2, 4>(F.lds, F.mix + (size_t)r0 * D, D, wptr(F, l, W_OUT) + (size_t)u * 16 * D, D, E, F.tid); }
            } else if (sub == 5) {
                const float* ssp = F.rsp + (size_t)(2 * l + 1) * MP * 16; const float* sss = F.rss + (size_t)(2 * l + 1) * 128 * 64;
                { pg8::Gemm g{F.xb, wptr(F, l, W_UP), MP, FF, D}; pg8::StaticOrder S; S.init(MP, FF, F.G, F.bid);
                  pg8::EpiScaleBf16<1> E{F.hid, FF, ssp};
                  pg8::gemm_phase<pg8::EpiScaleBf16<1>, pg8::StaticOrder, true, true>(F.lds, g, S, E, F.tid); }
                for (int u = F.bid; u < 256; u += F.G) { SkScaleBf16<1> E{F.hid + (size_t)MP * FF + u * 16, FF, sss}; skinny_unit<8, 2>(F.lds, F.xb + (size_t)MP * D, D, wptr(F, l, W_UP) + (size_t)u * 16 * D, D, E, F.tid); }
            } else {
                float* ssp = F.rsp + (size_t)(2 * l + 2) * MP * 16; float* sss = F.rss + (size_t)(2 * l + 2) * 128 * 64;
                { pg8::Gemm g{F.hid, wptr(F, l, W_DOWN), MP, D, FF}; pg8::StaticOrder S; S.init(MP, D, F.G, F.bid);
                  pg8::EpiRes E{F.xb, ssp};
                  pg8::gemm_phase<pg8::EpiRes, pg8::StaticOrder, true, true>(F.lds, g, S, E, F.tid); }
                for (int uu = F.bid; uu < 256; uu += F.G) { const int u = uu & 63, r0 = MP + (uu >> 6) * 32; SkRes E{F.xb + (size_t)r0 * D + u * 16, sss + (size_t)(r0 - MP) * 64, u}; skinny_unit<2, 8>(F.lds, F.hid + (size_t)r0 * FF, FF, wptr(F, l, W_DOWN) + (size_t)u * 16 * FF, FF, E, F.tid); }
            }
        }
        }
        if (ph + 1 < ph_hi) { if (coop) { if (ph == 0) grid.sync(); else { KArgs apb = ap0; asm volatile("" : "+s"(apb)); XcdBarrier xbar; xbar.bar = (unsigned*)(apb->ws + WS_CTL); xbar.x = xb_xcc_id(); xbar.st = (volatile LAS unsigned*)((LAS unsigned char*)lds_raw + MISC_OFF) + 8; xcd_barrier(xbar); if (PROBE_REP & 64) xcd_barrier(xbar); } } }
    }
}

#ifndef ONE_LAUNCH
#define ONE_LAUNCH 1
#endif
extern "C" void kernel_launch(void* const* d_in, const int* in_sizes, int n_in, void* d_out, int out_size, void* d_ws, size_t ws_size, hipStream_t stream) {
    static int grid = 0;
    if (grid == 0) {
        if (n_in != 16 || ws_size < WS_END) { fprintf(stderr, "kernel_launch: need 16 inputs and >= %zu bytes of workspace (got %d, %zu)\n", (size_t)WS_END, n_in, ws_size); grid = -1; return; }
        int dev = 0, cus = 0, per_cu = 0;
        hipGetDevice(&dev); hipDeviceGetAttribute(&cus, hipDeviceAttributeMultiprocessorCount, dev);
        if (hipFuncSetAttribute((const void*)hymba_fwd, hipFuncAttributeMaxDynamicSharedMemorySize, LDS_BYTES) != hipSuccess) { fprintf(stderr, "kernel_launch: hipFuncSetAttribute failed\n"); grid = -1; return; }
        if (hipOccupancyMaxActiveBlocksPerMultiprocessor(&per_cu, (const void*)hymba_fwd, 512, LDS_BYTES) != hipSuccess || per_cu < 1) { fprintf(stderr, "kernel_launch: occupancy query says %d\n", per_cu); per_cu = 1; }
        (void)hipGetLastError();
        grid = cus;
    }
    if (grid < 0) return;
    if (hipMemsetAsync((char*)d_ws + WS_CTL, 0, CTL_ZERO_BYTES, stream) != hipSuccess) { fprintf(stderr, "kernel_launch: hipMemsetAsync failed\n"); return; }
    Args a{};
    for (int i = 0; i < 16; ++i) a.in[i] = (const float*)d_in[i];
    a.out = (float*)d_out; a.ws = (unsigned char*)d_ws;
#if ONE_LAUNCH
    a.ph_lo = 0; a.ph_hi = NPHASE; a.coop = 1;
    void* kargs[] = {&a};
    hipError_t e = hipLaunchCooperativeKernel((const void*)hymba_fwd, dim3(grid), dim3(512), kargs, LDS_BYTES, stream);
    if (e != hipSuccess) fprintf(stderr, "cooperative launch failed: %s (grid %d)\n", hipGetErrorString(e), grid);
#else
    for (int ph = 0; ph < NPHASE; ++ph) { a.ph_lo = ph; a.ph_hi = ph + 1; a.coop = 0; hipLaunchKernelGGL(hymba_fwd, dim3(grid), dim3(512), LDS_BYTES, stream, a); }
#endif
}
```

```cpp
#include <hip/hip_runtime.h>
#include <hip/hip_cooperative_groups.h>
#include <cstdio>
#include <cstdint>
namespace cg = cooperative_groups;

#define LAS __attribute__((address_space(3)))
typedef unsigned short bf16_t;
typedef short bf16x8 __attribute__((ext_vector_type(8)));
typedef float f32x4 __attribute__((ext_vector_type(4)));
typedef float f32x2 __attribute__((ext_vector_type(2)));
typedef __bf16 bf16x2n __attribute__((ext_vector_type(2)));
typedef unsigned u32x4 __attribute__((ext_vector_type(4)));
typedef unsigned u32x2 __attribute__((ext_vector_type(2)));

constexpr int D = 1024, SEQ = 2048, NBATCH = 8, MP = NBATCH * SEQ, MS = 128, MT = MP + MS, DEPTH = 4;
constexpr int FF = 4096, INW = 2064, ZLD = 2048;
constexpr float EPS = 1e-6f;
constexpr int ZQ = 0, ZK = 256, ZV = 512, ZG = 1024, ZU = 1536;
constexpr size_t O_GLAP = (size_t)MT * D, O_POOLP = O_GLAP + 4 * 8 * 4 * 64 * 128, O_GLAS = O_POOLP + 4 * 8 * 15 * 512, O_POOLS = O_GLAS + (size_t)4 * 128 * 4 * 64 * 128;
constexpr size_t MiB = 1u << 20;
constexpr size_t WS_ALOW = 1 * MiB, WS_DEC = 3 * MiB, WS_W = 4 * MiB, W_STRIDE = 23 * MiB;
constexpr size_t W_IN = 0, W_OUT = 4 * MiB + 512 * 1024, W_UP = W_OUT + 2 * MiB, W_DOWN = W_UP + 8 * MiB, W_POOL = W_DOWN + 8 * MiB;
constexpr size_t WS_XB = 96 * MiB, WS_Z = 129 * MiB, WS_MIX = 194 * MiB, WS_HID = 129 * MiB, WS_KVT = 227 * MiB, WS_ST = 259 * MiB, WS_RSP = 275 * MiB, WS_RSS = 284 * MiB, WS_QKV = 285 * MiB, WS_END = 317 * MiB;
static_assert(W_POOL + 128 * 1024 <= W_STRIDE && WS_W + 4 * W_STRIDE <= WS_XB, "weight map");
constexpr int LDS_BYTES = 147456, MISC_OFF = 131072 + 320;
constexpr size_t WS_CTL = 0, CTL_ZERO_BYTES = 16384;
constexpr int NPHASE = 2 + 7 * DEPTH;

__device__ __forceinline__ unsigned cvtpk(float lo, float hi) { f32x2 v = {lo, hi}; bf16x2n b = __builtin_convertvector(v, bf16x2n); return __builtin_bit_cast(unsigned, b); }
__device__ __forceinline__ bf16_t f2bf(float f) { return (bf16_t)(cvtpk(f, 0.f) & 0xffffu); }
__device__ __forceinline__ float bf2f(bf16_t h) { return __uint_as_float((unsigned)h << 16); }
__device__ __forceinline__ float bflo(unsigned w) { return __uint_as_float(w << 16); }
__device__ __forceinline__ float bfhi(unsigned w) { return __uint_as_float(w & 0xffff0000u); }
__device__ __forceinline__ float wave_sum(float v) {
#pragma unroll
    for (int o = 1; o < 64; o <<= 1) v += __shfl_xor(v, o);
    return v;
}
#define LDS_WAIT() asm volatile("s_waitcnt lgkmcnt(0)" ::: "memory")

namespace pg8 {
constexpr int BM = 256, BK = 64, HALF = 128, HTB = HALF * BK * 2, STAGE_BYTES = 8 * HTB, NXCD = 8, WGM = 8;
__host__ __device__ __forceinline__ int lds_byte(int r, int c) { const int st = (r >> 4) * 2 + (c >> 5), rr = r & 15, cc = c & 31, ob = rr * 64 + cc * 2; return st * 1024 + (ob ^ (((ob >> 9) & 1) << 5)); }
__host__ __device__ __forceinline__ void stage_rc(int b, int& R, int& C) { const int st = b / 1024, sb = b % 1024, swz = sb ^ (((sb >> 9) & 1) << 5); R = (st >> 1) * 16 + swz / 64; C = (st & 1) * 32 + (swz % 64) / 2; }
__host__ __device__ __forceinline__ int perm32(int rho) { const int n = rho >> 4, i = rho & 15; return 8 * (i >> 2) + 4 * n + (i & 3); }
struct Unit { int pm, pn; };
struct Gemm { const bf16_t* A; const bf16_t* Bt; int M, N, K; };
struct StaticOrder {
    int nM, nN, nwg, G, c;
    __host__ __device__ void init(int M, int N, int G_, int c_) { nM = M / BM; nN = N / BM; nwg = nM * nN; G = G_; c = c_; }
    __host__ __device__ bool next(int i, Unit& u) const {
        const long L = (long)i * G + c; if (L >= nwg) return false;
        int wgid = (int)L; { const int q = nwg / NXCD, r = nwg % NXCD, xcd = wgid % NXCD, off = wgid / NXCD; wgid = (xcd < r ? xcd * (q + 1) : r * (q + 1) + (xcd - r) * q) + off; }
        const int nig = WGM * nN, gid = wgid / nig, fm = gid * WGM, gsz = (nM - fm) < WGM ? (nM - fm) : WGM;
        u.pm = fm + ((wgid % nig) % gsz); u.pn = (wgid % nig) / gsz; return true;
    }
    __device__ __forceinline__ void a_ready(const Unit&) const {}
    __device__ __forceinline__ void done(const Unit&) const {}
};

template <int ACT> struct EpiScaleBf16 {
    static constexpr bool PERM = true, AFTER_DRAIN = false;
    bf16_t* O; int ldc; const float* rowss;
    __device__ __forceinline__ void operator()(const f32x4 (&acc)[2][2][4][2], const Unit& u, int wr, int wc, int fr, int fq) const {
        const int row0 = u.pm * BM + wr * 64 + fr; const int col0 = u.pn * BM + wc * 32 + 8 * fq;
#pragma unroll
        for (int ai = 0; ai < 2; ++ai)
#pragma unroll
            for (int m = 0; m < 4; ++m) {
                const int row = row0 + ai * HALF + m * 16;
                const f32x4 s0 = *(const f32x4*)(rowss + (size_t)row * 16 + fq * 4);
                float tot = (s0[0] + s0[1]) + (s0[2] + s0[3]); tot += __shfl_xor(tot, 16); tot += __shfl_xor(tot, 32);
                const float rs = rsqrtf(tot * (1.0f / D) + EPS);
                bf16_t* rowp = O + (size_t)row * ldc + col0;
#pragma unroll
                for (int bj = 0; bj < 2; ++bj) {
                    f32x4 v0 = acc[ai][bj][m][0] * rs, v1 = acc[ai][bj][m][1] * rs;
                    if (ACT == 1) {
#pragma unroll
                        for (int e = 0; e < 4; ++e) { const float a = fmaxf(v0[e], 0.f), b = fmaxf(v1[e], 0.f); v0[e] = a * a; v1[e] = b * b; }
                    }
                    u32x4 w; w.x = cvtpk(v0[0], v0[1]); w.y = cvtpk(v0[2], v0[3]); w.z = cvtpk(v1[0], v1[1]); w.w = cvtpk(v1[2], v1[3]);
                    *(u32x4*)(rowp + bj * HALF) = w;
                }
            }
    }
};
struct EpiRes {
    static constexpr bool PERM = true, AFTER_DRAIN = false;
    bf16_t* XB; float* ssout;
    __device__ __forceinline__ void operator()(const f32x4 (&acc)[2][2][4][2], const Unit& u, int wr, int wc, int fr, int fq) const {
        const int row0 = u.pm * BM + wr * 64 + fr; const int col0 = u.pn * BM + wc * 32 + 8 * fq;
#pragma unroll
        for (int ai = 0; ai < 2; ++ai)
#pragma unroll
            for (int m = 0; m < 4; ++m) {
                const int row = row0 + ai * HALF + m * 16;
                bf16_t* br = XB + (size_t)row * D + col0;
                float ss = 0.f;
#pragma unroll
                for (int bj = 0; bj < 2; ++bj) {
                    const u32x4 xo = *(const u32x4*)(br + bj * HALF);
                    const f32x4 a0 = acc[ai][bj][m][0], a1 = acc[ai][bj][m][1];
                    u32x4 w; w.x = cvtpk(bflo(xo.x) + a0[0], bfhi(xo.x) + a0[1]); w.y = cvtpk(bflo(xo.y) + a0[2], bfhi(xo.y) + a0[3]);
                    w.z = cvtpk(bflo(xo.z) + a1[0], bfhi(xo.z) + a1[1]); w.w = cvtpk(bflo(xo.w) + a1[2], bfhi(xo.w) + a1[3]);
                    *(u32x4*)(br + bj * HALF) = w;
#pragma unroll
                    for (int e = 0; e < 4; ++e) { const float lo = bflo(w[e]), hi = bfhi(w[e]); ss += lo * lo + hi * hi; }
                }
                ss += __shfl_xor(ss, 16); ss += __shfl_xor(ss, 32);
                if (fq == 0) ssout[(size_t)row * 16 + u.pn * 4 + wc] = ss;
            }
    }
};
template <class Epi, class Sched, bool ALIGN_EPI = false, bool SP2 = false>
__device__ __forceinline__ void gemm_phase(LAS unsigned char* lds, const Gemm g, const Sched& S, const Epi& E, const int tid) {
    const int wid = __builtin_amdgcn_readfirstlane(tid >> 6), lane = tid & 63, wr = wid >> 2, wc = wid & 3, fr = lane & 15, fq = lane >> 4;
    const int K = g.K, nt = K / BK;
    unsigned voffA[2], voffB[2];
#pragma unroll
    for (int i = 0; i < 2; ++i) { int R, C; stage_rc(tid * 16 + i * 8192, R, C); const int Rb = Epi::PERM ? ((R & ~31) + perm32(R & 31)) : R;
        voffA[i] = (unsigned)(R * K + C) * 2u; voffB[i] = (unsigned)(Rb * K + C) * 2u; }
    const size_t kstep = (size_t)(BK * 2);
    const size_t hstep = (size_t)HALF * K * 2;
    const size_t tstep = 2 * hstep;
    const unsigned ldsw = (unsigned)wid * 1024u;
    const int aoff = lds_byte(wr * 64 + fr, fq * 8), boff = lds_byte(wc * 32 + fr, fq * 8);
#define PG8_SA(b, h) (((b) * 2 + (h)) * HTB)
#define PG8_SB(b, h) ((4 + (b) * 2 + (h)) * HTB)
#define PG8_STAGE(bufoff, gbase, voff) do { _Pragma("unroll") for (int _i = 0; _i < 2; ++_i) \
        __builtin_amdgcn_global_load_lds((const unsigned*)((const char*)(gbase) + (voff)[_i]), (LAS unsigned*)(lds + (bufoff) + ldsw + _i * 8192), 16, 0, 0); } while (0)
#define PG8_LDA(dst, b, h) do { _Pragma("unroll") for (int m = 0; m < 4; ++m) _Pragma("unroll") for (int k = 0; k < 2; ++k) dst[m][k] = *(const LAS bf16x8*)(lds + PG8_SA(b, h) + aoff + m * 2048 + k * 1024); } while (0)
#define PG8_LDB(dst, b, h) do { _Pragma("unroll") for (int n = 0; n < 2; ++n) _Pragma("unroll") for (int k = 0; k < 2; ++k) dst[n][k] = *(const LAS bf16x8*)(lds + PG8_SB(b, h) + boff + n * 2048 + k * 1024); } while (0)
#define PG8_MMA(ai, bj, At, Bt) do { __builtin_amdgcn_s_setprio(1); _Pragma("unroll") for (int m = 0; m < 4; ++m) _Pragma("unroll") for (int n = 0; n < 2; ++n) _Pragma("unroll") for (int k = 0; k < 2; ++k) \
        acc[ai][bj][m][n] = __builtin_amdgcn_mfma_f32_16x16x32_bf16(Bt[n][k], At[m][k], acc[ai][bj][m][n], 0, 0, 0); __builtin_amdgcn_s_setprio(0); } while (0)
#define PG8_WAIT_V(n) asm volatile("s_waitcnt vmcnt(" #n ")" ::: "memory")
#define PG8_WAIT_L(n) asm volatile("s_waitcnt lgkmcnt(" #n ")" ::: "memory")
#define PG8_BAR __builtin_amdgcn_s_barrier()
#define PG8_SCHED __builtin_amdgcn_sched_barrier(0)
    Unit cur, nxt; int ui = 0;
    if (!S.next(0, cur)) return;
    f32x4 acc[2][2][4][2];
#pragma unroll
    for (int a = 0; a < 2; ++a)
#pragma unroll
        for (int b = 0; b < 2; ++b)
#pragma unroll
            for (int m = 0; m < 4; ++m)
#pragma unroll
                for (int n = 0; n < 2; ++n) acc[a][b][m][n] = (f32x4){0.f, 0.f, 0.f, 0.f};
    bf16x8 At[4][2], B0[2][2], B1[2][2];
    const char* cA = (const char*)g.A + (size_t)cur.pm * tstep; const char* cB = (const char*)g.Bt + (size_t)cur.pn * tstep;
    S.a_ready(cur);
    if constexpr (SP2) {
        PG8_STAGE(PG8_SB(0, 0), cB, voffB); PG8_STAGE(PG8_SB(0, 1), cB + hstep, voffB); PG8_STAGE(PG8_SA(0, 0), cA, voffA); PG8_STAGE(PG8_SA(0, 1), cA + hstep, voffA);
        if (wr == 1) PG8_BAR;
        PG8_WAIT_V(2); PG8_BAR;
        PG8_STAGE(PG8_SB(1, 0), cB + kstep, voffB); PG8_STAGE(PG8_SA(1, 0), cA + kstep, voffA); PG8_STAGE(PG8_SB(1, 1), cB + hstep + kstep, voffB);
        PG8_WAIT_V(6); PG8_BAR;
    } else {
        PG8_STAGE(PG8_SB(0, 0), cB, voffB); PG8_STAGE(PG8_SA(0, 0), cA, voffA); PG8_STAGE(PG8_SB(0, 1), cB + hstep, voffB); PG8_STAGE(PG8_SA(0, 1), cA + hstep, voffA);
        if (wr == 1) PG8_BAR;
        PG8_WAIT_V(4); PG8_BAR;
        PG8_STAGE(PG8_SB(1, 0), cB + kstep, voffB); PG8_STAGE(PG8_SA(1, 0), cA + kstep, voffA); PG8_STAGE(PG8_SB(1, 1), cB + hstep + kstep, voffB);
        PG8_WAIT_V(6); PG8_BAR;
    }
    for (;;) {
        const bool has_next = S.next(ui + 1, nxt);
        const char* nA = has_next ? (const char*)g.A + (size_t)nxt.pm * tstep : cA; const char* nB = has_next ? (const char*)g.Bt + (size_t)nxt.pn * tstep : cB;
        for (int t = 0; t < nt; t += 2) {
            const bool last = (t == nt - 2);
            const char* a1 = cA + (size_t)(t + 1) * kstep;
            const char* a2 = last ? nA : cA + (size_t)(t + 2) * kstep; const char* b2 = last ? nB : cB + (size_t)(t + 2) * kstep;
            const char* a3 = a2 + kstep; const char* b3 = b2 + kstep;
            if (last && has_next) S.a_ready(nxt);
            if constexpr (SP2) {
            PG8_LDB(B0, 0, 0); PG8_LDB(B1, 0, 1); PG8_SCHED; PG8_LDA(At, 0, 0); PG8_STAGE(PG8_SA(1, 1), a1 + hstep, voffA);
            PG8_WAIT_V(8); PG8_WAIT_L(0); PG8_BAR; PG8_MMA(0, 0, At, B0); PG8_MMA(0, 1, At, B1); PG8_BAR; PG8_SCHED;
            PG8_LDA(At, 0, 1); PG8_STAGE(PG8_SB(0, 0), b2, voffB); PG8_STAGE(PG8_SB(0, 1), b2 + hstep, voffB); PG8_STAGE(PG8_SA(0, 0), a2, voffA);
            PG8_WAIT_V(8); PG8_WAIT_L(0); PG8_BAR; PG8_MMA(1, 0, At, B0); PG8_MMA(1, 1, At, B1); PG8_BAR; PG8_SCHED;
            PG8_LDB(B0, 1, 0); PG8_LDB(B1, 1, 1); PG8_SCHED; PG8_LDA(At, 1, 0); PG8_STAGE(PG8_SA(0, 1), a2 + hstep, voffA);
            PG8_WAIT_V(8); PG8_WAIT_L(0); PG8_BAR; PG8_MMA(0, 0, At, B0); PG8_MMA(0, 1, At, B1); PG8_BAR; PG8_SCHED;
            PG8_LDA(At, 1, 1); PG8_STAGE(PG8_SB(1, 0), b3, voffB); PG8_STAGE(PG8_SB(1, 1), b3 + hstep, voffB); PG8_STAGE(PG8_SA(1, 0), a3, voffA);
            PG8_WAIT_V(8); PG8_WAIT_L(0); PG8_BAR; PG8_MMA(1, 0, At, B0); PG8_MMA(1, 1, At, B1); PG8_BAR; PG8_SCHED;
            } else {
            PG8_LDB(B0, 0, 0); PG8_SCHED; PG8_LDA(At, 0, 0); PG8_STAGE(PG8_SA(1, 1), a1 + hstep, voffA);
            PG8_WAIT_L(8); PG8_BAR; PG8_WAIT_L(0); PG8_MMA(0, 0, At, B0); PG8_BAR; PG8_SCHED;
            PG8_LDB(B1, 0, 1); PG8_STAGE(PG8_SB(0, 0), b2, voffB);
            PG8_BAR; PG8_WAIT_L(0); PG8_MMA(0, 1, At, B1); PG8_BAR;
            PG8_LDA(At, 0, 1); PG8_STAGE(PG8_SA(0, 0), a2, voffA);
            PG8_BAR; PG8_WAIT_L(0); PG8_MMA(1, 0, At, B0); PG8_BAR; PG8_SCHED;
            PG8_STAGE(PG8_SB(0, 1), b2 + hstep, voffB);
            PG8_WAIT_V(6); PG8_BAR; PG8_MMA(1, 1, At, B1); PG8_BAR;
            PG8_LDB(B0, 1, 0); PG8_SCHED; PG8_LDA(At, 1, 0); PG8_STAGE(PG8_SA(0, 1), a2 + hstep, voffA);
            PG8_WAIT_L(8); PG8_BAR; PG8_WAIT_L(0); PG8_MMA(0, 0, At, B0); PG8_BAR; PG8_SCHED;
            PG8_LDB(B1, 1, 1); PG8_STAGE(PG8_SB(1, 0), b3, voffB);
            PG8_BAR; PG8_WAIT_L(0); PG8_MMA(0, 1, At, B1); PG8_BAR;
            PG8_LDA(At, 1, 1); PG8_STAGE(PG8_SA(1, 0), a3, voffA);
            PG8_BAR; PG8_WAIT_L(0); PG8_MMA(1, 0, At, B0); PG8_BAR; PG8_SCHED;
            PG8_STAGE(PG8_SB(1, 1), b3 + hstep, voffB);
            PG8_WAIT_V(6); PG8_BAR; PG8_MMA(1, 1, At, B1); PG8_BAR;
            }
        }
        if constexpr (ALIGN_EPI) { if (wr == 0) PG8_BAR; }
        if constexpr (!Epi::AFTER_DRAIN) { E(acc, cur, wr, wc, fr, fq); S.done(cur); }
        if (!has_next) break;
#pragma unroll
        for (int a = 0; a < 2; ++a)
#pragma unroll
            for (int b = 0; b < 2; ++b)
#pragma unroll
                for (int m = 0; m < 4; ++m)
#pragma unroll
                    for (int n = 0; n < 2; ++n) acc[a][b][m][n] = (f32x4){0.f, 0.f, 0.f, 0.f};
        cur = nxt; cA = nA; cB = nB; ++ui;
        if constexpr (ALIGN_EPI) { if (wr == 1) PG8_BAR; }
    }
    PG8_WAIT_V(0);
    if constexpr (!ALIGN_EPI) { if (wr == 0) PG8_BAR; }
    PG8_BAR;
#undef PG8_SA
#undef PG8_SB
#undef PG8_STAGE
#undef PG8_LDA
#undef PG8_LDB
#undef PG8_MMA
#undef PG8_WAIT_V
#undef PG8_WAIT_L
#undef PG8_BAR
#undef PG8_SCHED
}
}

template <int MTN, int UNR, class Epi>
__device__ __forceinline__ void skinny_unit(LAS unsigned char* lds, const bf16_t* A, int lda, const bf16_t* Bt, int K, const Epi& E, const int tid) {
    const int wid = __builtin_amdgcn_readfirstlane(tid >> 6), lane = tid & 63, fr = lane & 15, fq = lane >> 4;
    const int kw = K / 8, k0 = wid * kw;
    f32x4 acc[MTN];
#pragma unroll
    for (int m = 0; m < MTN; ++m) acc[m] = (f32x4){0.f, 0.f, 0.f, 0.f};
    const bf16_t* ap = A + (size_t)fr * lda + k0 + fq * 8;
    const bf16_t* bp = Bt + (size_t)fr * K + k0 + fq * 8;
    for (int ks = 0; ks < kw; ks += 32 * UNR) {
        bf16x8 b[UNR], a[UNR][MTN];
#pragma unroll
        for (int u = 0; u < UNR; ++u) { b[u] = *(const bf16x8*)(bp + ks + u * 32);
#pragma unroll
            for (int m = 0; m < MTN; ++m) a[u][m] = *(const bf16x8*)(ap + (size_t)(m * 16) * lda + ks + u * 32); }
#pragma unroll
        for (int u = 0; u < UNR; ++u)
#pragma unroll
            for (int m = 0; m < MTN; ++m) acc[m] = __builtin_amdgcn_mfma_f32_16x16x32_bf16(a[u][m], b[u], acc[m], 0, 0, 0);
    }
    constexpr int ROWS = MTN * 16;
    LAS float* part = (LAS float*)lds;
#pragma unroll
    for (int m = 0; m < MTN; ++m)
#pragma unroll
        for (int j = 0; j < 4; ++j) part[(wid * ROWS + m * 16 + fq * 4 + j) * 16 + fr] = acc[m][j];
    __syncthreads();
    if (tid < ROWS * 4) {
        const int row = tid >> 2, c4 = (tid & 3) * 4;
        f32x4 s = (f32x4){0.f, 0.f, 0.f, 0.f};
#pragma unroll
        for (int w = 0; w < 8; ++w) s = s + *(const LAS f32x4*)(part + (w * ROWS + row) * 16 + c4);
        E(row, c4, s, tid);
    }
    __syncthreads();
}
template <int NS> __device__ __forceinline__ float sk_rstd(const float* base, int row, int tid) {
    const f32x4* p = (const f32x4*)(base + (size_t)row * NS + (tid & 3) * (NS / 4)); float s = 0.f;
#pragma unroll
    for (int i = 0; i < NS / 16; ++i) { const f32x4 v = p[i]; s += (v[0] + v[1]) + (v[2] + v[3]); }
    s += __shfl_xor(s, 1); s += __shfl_xor(s, 2);
    return rsqrtf(s * (1.0f / D) + EPS);
}
template <int NS> struct SkAlow { float* O; const float* rowss; __device__ __forceinline__ void operator()(int row, int c4, f32x4 v, int tid) const {
    const float rs = sk_rstd<NS>(rowss, row, tid); *(f32x4*)(O + (size_t)row * 16 + c4) = v * rs; } };
template <int ACT> struct SkScaleBf16 { bf16_t* O; int ldc; const float* rowss; __device__ __forceinline__ void operator()(int row, int c4, f32x4 v, int tid) const {
    const float rs = sk_rstd<64>(rowss, row, tid); v = v * rs;
    if (ACT == 1) {
#pragma unroll
        for (int e = 0; e < 4; ++e) { const float a = fmaxf(v[e], 0.f); v[e] = a * a; } }
    u32x2 w; w.x = cvtpk(v[0], v[1]); w.y = cvtpk(v[2], v[3]); *(u32x2*)(O + (size_t)row * ldc + c4) = w; } };
struct SkRes { bf16_t* XB; float* ssout; int slot; __device__ __forceinline__ void operator()(int row, int c4, f32x4 v, int tid) const {
    const u32x2 xo = *(const u32x2*)(XB + (size_t)row * D + c4);
    u32x2 w; w.x = cvtpk(bflo(xo.x) + v[0], bfhi(xo.x) + v[1]); w.y = cvtpk(bflo(xo.y) + v[2], bfhi(xo.y) + v[3]); *(u32x2*)(XB + (size_t)row * D + c4) = w;
    float ss = (bflo(w.x) * bflo(w.x) + bfhi(w.x) * bfhi(w.x)) + (bflo(w.y) * bflo(w.y) + bfhi(w.y) * bfhi(w.y)); ss += __shfl_xor(ss, 1); ss += __shfl_xor(ss, 2);
    if ((tid & 3) == 0) ssout[(size_t)row * 64 + slot] = ss; } };

#define XB_TMO      128
#define XB_XCNT(j)  (256  + 64 * (j))
#define XB_XSUB(j)  (1280 + 64 * (j))
#define XB_XGEN(j)  (2304 + 64 * (j))
#define XB_TOP      3328
#define XB_TOPGEN   3392
#define XCD_BAR_WORDS 3456
#define XB_SPIN_CAP (1u << 18)
__device__ __forceinline__ unsigned xb_ld(unsigned* p)              { return __hip_atomic_load(p, __ATOMIC_RELAXED, __HIP_MEMORY_SCOPE_AGENT); }
__device__ __forceinline__ unsigned xb_add(unsigned* p, unsigned v) { return __hip_atomic_fetch_add(p, v, __ATOMIC_RELAXED, __HIP_MEMORY_SCOPE_AGENT); }
__device__ __forceinline__ unsigned xb_xcc_id() { return (unsigned)__builtin_amdgcn_s_getreg((3 << 11) | 20) & 0xFu; }
#define XB_SPIN(cond, bar) do { unsigned _sp = 0; while (cond) { __builtin_amdgcn_s_sleep(1); \
    if ((++_sp & 255u) == 0u) { if (xb_ld(&(bar)[XB_TMO])) break; if (_sp > XB_SPIN_CAP) { atomicAdd(&(bar)[XB_TMO], 1u); break; } } } } while (0)
struct XcdBarrier { unsigned* bar; unsigned x; volatile LAS unsigned* st; };
__device__ __forceinline__ XcdBarrier xcd_barrier_post(unsigned* bar, volatile LAS unsigned* st) {
    XcdBarrier b; b.bar = bar; b.x = xb_xcc_id(); b.st = st;
    if (threadIdx.x == 0) (void)xb_add(&bar[XB_XCNT(b.x)], 1u);
    return b;
}
__device__ __forceinline__ void xcd_barrier_complete(unsigned* bar, unsigned x, unsigned& nloc, unsigned& nx) {
    const unsigned G = gridDim.x * gridDim.y * gridDim.z;
    unsigned sum, cnt, mine, sp = 0u;
    for (;;) {
        sum = 0u; cnt = 0u; mine = 0u;
#pragma unroll
        for (unsigned j = 0; j < 16; ++j) { const unsigned c = xb_ld(&bar[XB_XCNT(j)]); sum += c; cnt += (c > 0u) ? 1u : 0u; mine = (j == x) ? c : mine; }
        if (sum == G) break;
        __builtin_amdgcn_s_sleep(1);
        if ((++sp & 255u) == 0u) { if (xb_ld(&bar[XB_TMO])) break; if (sp > XB_SPIN_CAP) { atomicAdd(&bar[XB_TMO], 1u); break; } }
    }
    nloc = mine > 0u ? mine : 1u; nx = cnt > 0u ? cnt : 1u;
}
__device__ __forceinline__ void xcd_barrier(const XcdBarrier& b) {
    asm volatile("s_waitcnt vmcnt(0)" ::: "memory");
    __syncthreads();
    if (threadIdx.x == 0) {
        unsigned* bar = b.bar;
        __builtin_amdgcn_s_waitcnt(0);
        unsigned nloc = b.st[0], nx = b.st[1];
        if (nloc == 0u) { xcd_barrier_complete(bar, b.x, nloc, nx); b.st[0] = nloc; b.st[1] = nx; }
        const unsigned old = xb_add(&bar[XB_XSUB(b.x)], 1u);
        const unsigned gen = old / nloc;
        if (old + 1u == (gen + 1u) * nloc) {
            __builtin_amdgcn_fence(__ATOMIC_RELEASE, "agent");
            asm volatile("s_waitcnt vmcnt(0)" ::: "memory");
            const unsigned og = xb_add(&bar[XB_TOP], 1u);
            const unsigned tg = og / nx;
            if (og + 1u == (tg + 1u) * nx) xb_add(&bar[XB_TOPGEN], 1u);
            else XB_SPIN(xb_ld(&bar[XB_TOPGEN]) == tg, bar);
            __builtin_amdgcn_fence(__ATOMIC_ACQUIRE, "");
            xb_add(&bar[XB_XGEN(b.x)], 1u);
            asm volatile("s_waitcnt vmcnt(0)" ::: "memory");
        } else {
            __builtin_amdgcn_fence(__ATOMIC_ACQUIRE, "");
            XB_SPIN(xb_ld(&bar[XB_XGEN(b.x)]) == gen, bar);
            asm volatile("s_waitcnt vmcnt(0)" ::: "memory");
        }
    }
    __syncthreads();
}

struct Args { const float* in[16]; float* out; unsigned char* ws; int ph_lo, ph_hi, coop, pad; };
struct Frame {
    LAS unsigned char* lds; int tid, lane, wave, G, bid;
    const float *x_prompt, *x_sample, *state_gla, *state_pool, *norm1_g, *w_in, *w_gate, *b_gate, *gla_norm_g, *pool_w, *pool_scale, *w_out, *norm2_g, *w_up, *w_down, *final_g;
    float* out; unsigned char* ws;
    float *rsp, *rss, *alow, *dec, *kvt; bf16_t *xb, *z, *mix, *hid, *st, *qt, *kt, *vt;
};
__device__ __forceinline__ bf16_t* wptr(const Frame& F, int l, size_t off) { return (bf16_t*)(F.ws + WS_W + (size_t)l * W_STRIDE + off); }

struct TItem { const float* W; bf16_t* WT; const float* kscale; int ldw, K, k0, nsrc0, ndst0, nvalid; };
struct TRegs { f32x4 v[8]; float ks[8]; };
__device__ __forceinline__ void titem_decode(const Frame& F, int it, TItem& T) {
    constexpr int I_IN = 16 * 65, I_OUT = 16 * 32, I_UP = 16 * 128, I_DOWN = 64 * 32, I_POOL = 32, I_LAYER = I_IN + I_OUT + I_UP + I_DOWN + I_POOL;
    const int l = it / I_LAYER; int r = it % I_LAYER;
    if (r < I_IN) { const int kb = r / 65, nb = r % 65, nd = nb * 32;
        T = TItem{F.w_in + (size_t)l * D * INW, wptr(F, l, W_IN), F.norm1_g + l * D, INW, D, kb * 64, nd < 1536 ? nd : (nd < 2048 ? nd + 16 : 1536), nd, nd < 2048 ? 32 : 16}; return; } r -= I_IN;
    if (r < I_OUT) { const int kb = r / 32, nb = r % 32; T = TItem{F.w_out + (size_t)l * D * D, wptr(F, l, W_OUT), nullptr, D, D, kb * 64, nb * 32, nb * 32, 32}; return; } r -= I_OUT;
    if (r < I_UP) { const int kb = r / 128, nb = r % 128; T = TItem{F.w_up + (size_t)l * D * FF, wptr(F, l, W_UP), F.norm2_g + l * D, FF, D, kb * 64, nb * 32, nb * 32, 32}; return; } r -= I_UP;
    if (r < I_DOWN) { const int kb = r / 32, nb = r % 32; T = TItem{F.w_down + (size_t)l * FF * D, wptr(F, l, W_DOWN), nullptr, D, FF, kb * 64, nb * 32, nb * 32, 32}; return; } r -= I_DOWN;
    { const int g = r / 8, kb = (r % 8) / 4, nb = r % 4; T = TItem{F.pool_w + ((size_t)l * 4 + g) * 128 * 128, wptr(F, l, W_POOL) + g * 16384, nullptr, 128, 128, kb * 64, nb * 32, nb * 32, 32}; }
}
__device__ __forceinline__ void titem_load(const TItem& T, TRegs& R, int lane) {
    const int c4 = (lane & 7) * 4, kr = lane >> 3;
#pragma unroll
    for (int i = 0; i < 8; ++i) { const int kk = 8 * i + kr; R.v[i] = (c4 < T.nvalid) ? *(const f32x4*)(T.W + (size_t)(T.k0 + kk) * T.ldw + T.nsrc0 + c4) : (f32x4){0.f, 0.f, 0.f, 0.f}; R.ks[i] = T.kscale ? T.kscale[T.k0 + kk] : 1.0f; }
}
__device__ __forceinline__ void titem_store(const TItem& T, const TRegs& R, LAS float* scr, int lane) {
    const int c4 = (lane & 7) * 4, kr = lane >> 3;
#pragma unroll
    for (int i = 0; i < 8; ++i) { const int kk = 8 * i + kr;
#pragma unroll
        for (int e = 0; e < 4; ++e) scr[kk * 33 + c4 + e] = R.v[i][e] * R.ks[i]; }
    LDS_WAIT(); asm volatile("" ::: "memory");
    const int c8 = lane & 7;
#pragma unroll
    for (int j = 0; j < 4; ++j) { const int n = (lane >> 3) + 8 * j; const LAS float* s = scr + (8 * c8) * 33 + n;
        u32x4 o; o.x = cvtpk(s[0 * 33], s[1 * 33]); o.y = cvtpk(s[2 * 33], s[3 * 33]); o.z = cvtpk(s[4 * 33], s[5 * 33]); o.w = cvtpk(s[6 * 33], s[7 * 33]);
        if (n < T.nvalid) *(u32x4*)(T.WT + (size_t)(T.ndst0 + n) * T.K + T.k0 + 8 * c8) = o; }
    LDS_WAIT(); asm volatile("" ::: "memory");
}
__device__ __forceinline__ void p0_prologue(Frame& F) {
    LAS float* scr = (LAS float*)(F.lds + F.wave * 8704);
    const int gw = F.bid * 8 + F.wave, NGW = F.G * 8;
    constexpr int NITEMS = DEPTH * (16 * 65 + 16 * 32 + 16 * 128 + 64 * 32 + 32);
    {
        TItem T0, T1; TRegs R0, R1;
        if (gw < NITEMS) { titem_decode(F, gw, T0); titem_load(T0, R0, F.lane); }
        for (int it = gw; it < NITEMS; it += NGW) {
            const bool more = it + NGW < NITEMS;
            if (more) { titem_decode(F, it + NGW, T1); titem_load(T1, R1, F.lane); }
            titem_store(T0, R0, scr, F.lane);
            if (more) { T0 = T1; R0 = R1; }
        }
    }
    f32x4 v0[4], v1[4];
    if (gw < MT) { const float* src = gw < MP ? F.x_prompt + (size_t)gw * D : F.x_sample + (size_t)(gw - MP) * D;
#pragma unroll
        for (int j = 0; j < 4; ++j) v0[j] = ((const f32x4*)src + F.lane)[64 * j]; }
    for (int m = gw; m < MT; m += NGW) {
        const int mn = m + NGW;
        if (mn < MT) { const float* src = mn < MP ? F.x_prompt + (size_t)mn * D : F.x_sample + (size_t)(mn - MP) * D;
#pragma unroll
            for (int j = 0; j < 4; ++j) v1[j] = ((const f32x4*)src + F.lane)[64 * j]; }
        u32x2* bo = (u32x2*)(F.xb + (size_t)m * D) + F.lane;
        float s = 0.f;
#pragma unroll
        for (int j = 0; j < 4; ++j) { const f32x4 v = v0[j]; u32x2 w; w.x = cvtpk(v[0], v[1]); w.y = cvtpk(v[2], v[3]); bo[64 * j] = w; s += (v[0] * v[0] + v[1] * v[1]) + (v[2] * v[2] + v[3] * v[3]); }
        s = wave_sum(s);
        if (m < MP) { if (F.lane < 16) F.rsp[(size_t)m * 16 + F.lane] = F.lane == 0 ? s : 0.f; }
        else F.rss[(size_t)(m - MP) * 64 + F.lane] = F.lane == 0 ? s : 0.f;
        if (mn < MT) {
#pragma unroll
            for (int j = 0; j < 4; ++j) v0[j] = v1[j]; }
    }
}

constexpr int L_AL = 0, L_B = 4096, L_TOT = 20736, L_BL = 22784, L_QT = 23040, L_KT = 32256, L_VT = 41472, L_ATT = 59904, L_SS = 69120;
__device__ __forceinline__ float logsig(float x) { return fminf(x, 0.f) - __logf(1.f + __expf(-fabsf(x))); }
__device__ __forceinline__ float rdlane(float v, int lane) { return __int_as_float(__builtin_amdgcn_readlane(__float_as_int(v), lane)); }
struct KvC { float w[16]; float bj; };
struct KvU { f32x4 alv; bf16_t qv[8], kv[8]; u32x4 vv[2]; };
__device__ __forceinline__ void gla_kv_loadc(const Frame& F, int l, int h, KvC& C) {
    const int j = F.tid & 63; const float* wg = F.w_gate + (size_t)l * 16 * 256 + h * 64 + j;
#pragma unroll
    for (int r = 0; r < 16; ++r) C.w[r] = wg[r * 256];
    C.bj = F.b_gate[l * 256 + h * 64 + j];
}
__device__ __forceinline__ void gla_kv_load(const Frame& F, int unit, KvU& U) {
    const int bh = unit >> 5, n = unit & 31, b = bh >> 2, h = bh & 3, row0 = b * SEQ + n * 64, tid = F.tid, j = tid & 63, cgp = F.wave;
    const bf16_t* zrow0 = F.z + (size_t)row0 * ZLD;
    const float* al = F.alow + (size_t)(row0 + cgp * 8) * 16;
    U.alv = (f32x4){0.f, 0.f, 0.f, 0.f}; if (F.lane < 32) U.alv = *(const f32x4*)(al + F.lane * 4);
#pragma unroll
    for (int i = 0; i < 8; ++i) { const bf16_t* zr = zrow0 + (size_t)(cgp * 8 + i) * ZLD + h * 64 + j; U.qv[i] = zr[ZQ]; U.kv[i] = zr[ZK]; }
#pragma unroll
    for (int pass = 0; pass < 2; ++pass) U.vv[pass] = *(const u32x4*)(zrow0 + (size_t)((tid >> 4) + pass * 32) * ZLD + ZV + h * 128 + (tid & 15) * 8);
}
__device__ __forceinline__ void gla_kv_unit(const Frame& F, int l, int unit, const KvC& C, const KvU& U) {
    const int tid = F.tid;
    LAS float* sTot = (LAS float*)(F.lds + L_TOT);
    LAS bf16_t* sQt = (LAS bf16_t*)(F.lds + L_QT); LAS bf16_t* sKt = (LAS bf16_t*)(F.lds + L_KT); LAS bf16_t* sKeT = (LAS bf16_t*)(F.lds + L_ATT); LAS bf16_t* sVT = (LAS bf16_t*)(F.lds + L_VT);
    const int j = tid & 63, cgp = F.wave;
    const f32x4 alv = U.alv; const float bj = C.bj;
    float loc[8]; float run = 0.f;
#pragma unroll
    for (int i = 0; i < 8; ++i) { float ga = bj;
#pragma unroll
        for (int r = 0; r < 16; ++r) ga += rdlane(alv[r & 3], i * 4 + (r >> 2)) * C.w[r];
        run += logsig(ga) * (1.0f / 16.0f); loc[i] = run; }
    sTot[cgp * 64 + j] = run;
#pragma unroll
    for (int pass = 0; pass < 2; ++pass) { const int vg = tid & 15, sidx = (tid >> 4) + pass * 32;
#pragma unroll
        for (int i = 0; i < 4; ++i) { sVT[(vg * 8 + 2 * i) * 72 + sidx] = (bf16_t)(U.vv[pass][i] & 0xffffu); sVT[(vg * 8 + 2 * i + 1) * 72 + sidx] = (bf16_t)(U.vv[pass][i] >> 16); } }
    __syncthreads();
    float off = 0.f, tot = 0.f;
#pragma unroll
    for (int g = 0; g < 8; ++g) { const float tv = sTot[g * 64 + j]; off += (g < cgp) ? tv : 0.f; tot += tv; }
    u32x4 kep;
#pragma unroll
    for (int i = 0; i < 8; i += 2) {
        const float b0 = off + loc[i], b1 = off + loc[i + 1];
        const float q0 = bf2f(U.qv[i]), q1 = bf2f(U.qv[i + 1]), k0 = bf2f(U.kv[i]), k1 = bf2f(U.kv[i + 1]);
        sQt[(cgp * 8 + i) * 72 + j] = f2bf(q0 * __expf(b0) * 0.125f); sQt[(cgp * 8 + i + 1) * 72 + j] = f2bf(q1 * __expf(b1) * 0.125f);
        sKt[(cgp * 8 + i) * 72 + j] = f2bf(k0 * __expf(-b0)); sKt[(cgp * 8 + i + 1) * 72 + j] = f2bf(k1 * __expf(-b1));
        kep[i >> 1] = cvtpk(k0 * __expf(tot - b0), k1 * __expf(tot - b1)); }
    *(LAS u32x4*)(sKeT + j * 72 + cgp * 8) = kep;
    if (cgp == 0) F.dec[unit * 64 + j] = __expf(tot);
    __syncthreads();
    const int wv = F.wave, fr = F.lane & 15, fq = F.lane >> 4;
    f32x4 acc[4];
#pragma unroll
    for (int nt = 0; nt < 4; ++nt) acc[nt] = (f32x4){0.f, 0.f, 0.f, 0.f};
#pragma unroll
    for (int ks = 0; ks < 2; ++ks) { const bf16x8 a = *(const LAS bf16x8*)(sVT + (wv * 16 + fr) * 72 + ks * 32 + fq * 8);
#pragma unroll
        for (int nt = 0; nt < 4; ++nt) { const bf16x8 bb = *(const LAS bf16x8*)(sKeT + (nt * 16 + fr) * 72 + ks * 32 + fq * 8); acc[nt] = __builtin_amdgcn_mfma_f32_16x16x32_bf16(a, bb, acc[nt], 0, 0, 0); } }
    { const int sr = tid >> 3, kg = tid & 7;
      *(u32x4*)(F.qt + (size_t)unit * 4096 + sr * 64 + kg * 8) = *(const LAS u32x4*)(sQt + sr * 72 + kg * 8);
      *(u32x4*)(F.kt + (size_t)unit * 4096 + sr * 64 + kg * 8) = *(const LAS u32x4*)(sKt + sr * 72 + kg * 8);
#pragma unroll
      for (int p = 0; p < 2; ++p) { const int id = tid + 512 * p, vc = id >> 3, ch = id & 7; *(u32x4*)(F.vt + (size_t)unit * 8192 + vc * 64 + ch * 8) = *(const LAS u32x4*)(sVT + vc * 72 + ch * 8); } }
    float* kvt = F.kvt + (size_t)unit * 8192;
#pragma unroll
    for (int nt = 0; nt < 4; ++nt)
#pragma unroll
        for (int jj = 0; jj < 4; ++jj) kvt[(wv * 16 + fq * 4 + jj) * 64 + nt * 16 + fr] = acc[nt][jj];
    __syncthreads();
}
struct OutU { u32x4 q16, k16, v16[2]; bf16x8 bs[4][2]; bf16_t gzr[4][4]; };
__device__ __forceinline__ void gla_out_load(const Frame& F, int unit, OutU& U) {
    const int bh = unit >> 5, n = unit & 31, b = bh >> 2, h = bh & 3, row0 = b * SEQ + n * 64;
    const bf16_t* zrow0 = F.z + (size_t)row0 * ZLD;
    const int w = F.wave, fr = F.lane & 15, fq = F.lane >> 4, mt = w >> 1, nt4 = (w & 1) * 4, sr = F.tid >> 3, kg = F.tid & 7;
    U.q16 = *(const u32x4*)(F.qt + (size_t)unit * 4096 + sr * 64 + kg * 8); U.k16 = *(const u32x4*)(F.kt + (size_t)unit * 4096 + sr * 64 + kg * 8);
#pragma unroll
    for (int p = 0; p < 2; ++p) { const int id = F.tid + 512 * p; U.v16[p] = *(const u32x4*)(F.vt + (size_t)unit * 8192 + (id >> 3) * 64 + (id & 7) * 8); }
    const bf16_t* stg = F.st + (size_t)unit * 8192;
#pragma unroll
    for (int q = 0; q < 4; ++q)
#pragma unroll
        for (int ks = 0; ks < 2; ++ks) U.bs[q][ks] = *(const bf16x8*)(stg + ((nt4 + q) * 16 + fr) * 64 + ks * 32 + fq * 8);
#pragma unroll
    for (int j = 0; j < 4; ++j)
#pragma unroll
        for (int q = 0; q < 4; ++q) U.gzr[j][q] = zrow0[(size_t)(mt * 16 + fq * 4 + j) * ZLD + ZG + h * 128 + (nt4 + q) * 16 + fr];
}
__device__ __forceinline__ void gla_out_unit_v3(const Frame& F, int l, int unit, const OutU& U, const float (&gnv)[4]) {
    const int bh = unit >> 5, n = unit & 31, b = bh >> 2, h = bh & 3, row0 = b * SEQ + n * 64;
    LAS float* sSS = (LAS float*)(F.lds + L_SS);
    LAS bf16_t* sQt = (LAS bf16_t*)(F.lds + L_QT); LAS bf16_t* sKt = (LAS bf16_t*)(F.lds + L_KT); LAS bf16_t* sVT = (LAS bf16_t*)(F.lds + L_VT); LAS bf16_t* sAtt = (LAS bf16_t*)(F.lds + L_ATT);
    const int w = F.wave, fr = F.lane & 15, fq = F.lane >> 4, mt = w >> 1, nt4 = (w & 1) * 4;
    { const int sr = F.tid >> 3, kg = F.tid & 7;
      *(LAS u32x4*)(sQt + sr * 72 + kg * 8) = U.q16; *(LAS u32x4*)(sKt + sr * 72 + kg * 8) = U.k16;
#pragma unroll
      for (int p = 0; p < 2; ++p) { const int id = F.tid + 512 * p; *(LAS u32x4*)(sVT + (id >> 3) * 72 + (id & 7) * 8) = U.v16[p]; } }
    __syncthreads();
#pragma unroll
    for (int q = 0; q < 2; ++q) { const int nt = (w & 1) * 2 + q;
        f32x4 acc = (f32x4){0.f, 0.f, 0.f, 0.f};
        if (nt <= mt) {
#pragma unroll
            for (int ks = 0; ks < 2; ++ks) { const bf16x8 a = *(const LAS bf16x8*)(sQt + (mt * 16 + fr) * 72 + ks * 32 + fq * 8); const bf16x8 bb = *(const LAS bf16x8*)(sKt + (nt * 16 + fr) * 72 + ks * 32 + fq * 8);
                acc = __builtin_amdgcn_mfma_f32_16x16x32_bf16(a, bb, acc, 0, 0, 0); } }
#pragma unroll
        for (int j = 0; j < 4; ++j) { const int c = mt * 16 + fq * 4 + j, s = nt * 16 + fr; sAtt[c * 72 + s] = f2bf(s <= c ? acc[j] : 0.f); } }
    __syncthreads();
    f32x4 o[4];
#pragma unroll
    for (int q = 0; q < 4; ++q) o[q] = (f32x4){0.f, 0.f, 0.f, 0.f};
#pragma unroll
    for (int ks = 0; ks < 2; ++ks) {
        const bf16x8 a1 = *(const LAS bf16x8*)(sAtt + (mt * 16 + fr) * 72 + ks * 32 + fq * 8); const bf16x8 a2 = *(const LAS bf16x8*)(sQt + (mt * 16 + fr) * 72 + ks * 32 + fq * 8);
#pragma unroll
        for (int q = 0; q < 4; ++q) { const int nt = nt4 + q;
            const bf16x8 bv = *(const LAS bf16x8*)(sVT + (nt * 16 + fr) * 72 + ks * 32 + fq * 8);
            o[q] = __builtin_amdgcn_mfma_f32_16x16x32_bf16(a1, bv, o[q], 0, 0, 0); o[q] = __builtin_amdgcn_mfma_f32_16x16x32_bf16(a2, U.bs[q][ks], o[q], 0, 0, 0); } }
    float p[4];
#pragma unroll
    for (int j = 0; j < 4; ++j) { float s = 0.f;
#pragma unroll
        for (int q = 0; q < 4; ++q) s += o[q][j] * o[q][j];
        s += __shfl_xor(s, 1); s += __shfl_xor(s, 2); s += __shfl_xor(s, 4); s += __shfl_xor(s, 8); p[j] = s; }
    if (fr == 0) {
#pragma unroll
        for (int j = 0; j < 4; ++j) sSS[(w & 1) * 64 + mt * 16 + fq * 4 + j] = p[j]; }
    __syncthreads();
#pragma unroll
    for (int j = 0; j < 4; ++j) { const int c = mt * 16 + fq * 4 + j; const float rs = rsqrtf((sSS[c] + sSS[64 + c]) * (1.0f / 128.0f) + EPS);
#pragma unroll
        for (int q = 0; q < 4; ++q) { const int vcol = (nt4 + q) * 16 + fr; const float gz = bf2f(U.gzr[j][q]);
            const float val = o[q][j] * rs * gnv[q] * (gz / (1.f + __expf(-gz)));
            F.mix[(size_t)(row0 + c) * D + h * 128 + vcol] = f2bf(val); } }
    __syncthreads();
}
__device__ __forceinline__ void gla_scan_elem(const Frame& F, int l, int e) {
    const int bh = e >> 12, idx = (e & 4095) * 2, k = idx & 63, vcol = idx >> 6;
    const float* kv = F.kvt + (size_t)bh * 32 * 8192 + idx; const float* dc = F.dec + bh * 32 * 64 + k; bf16_t* st = F.st + (size_t)bh * 32 * 8192 + idx;
    f32x2 S = (f32x2){0.f, 0.f};
#pragma unroll 8
    for (int n = 0; n < 32; ++n) { *(unsigned*)(st + (size_t)n * 8192) = cvtpk(S[0], S[1]);
        const f32x2 d = *(const f32x2*)(dc + n * 64), x = *(const f32x2*)(kv + (size_t)n * 8192); S = d * S + x; }
    float* o = F.out + O_GLAP + ((size_t)l * 32 + bh) * 8192 + k * 128 + vcol;
    o[0] = S[0]; o[128] = S[1];
}
__device__ __forceinline__ void gla_scan(const Frame& F, int l) {
    if (F.G == 256) { const int b = F.bid & 7, j = F.bid >> 3; gla_scan_elem(F, l, (b * 4 + (j >> 3)) * 4096 + (j & 7) * 512 + F.tid); }
    else for (int e = F.bid * 512 + F.tid; e < 32 * 4096; e += F.G * 512) gla_scan_elem(F, l, e);
}
__device__ __forceinline__ void gla_decode_unit(const Frame& F, int l, int unit) {
    const int s = unit >> 2, h = unit & 3, row = MP + s, tid = F.tid;
    const bf16_t* zrow = F.z + (size_t)row * ZLD;
    LAS float* sA = (LAS float*)(F.lds); LAS float* sQ = sA + 64; LAS float* sK = sA + 128; LAS float* sO = sA + 192; LAS float* sRed = sA + 192 + 512;
    const int v = tid & 127, kg = tid >> 7;
    const size_t soff = (((size_t)l * 128 + s) * 4 + h) * 8192;
    const float* S0 = F.state_gla + soff; float* Sn = F.out + O_GLAS + soff;
    float s0r[16];
#pragma unroll
    for (int i = 0; i < 16; ++i) s0r[i] = S0[(kg * 16 + i) * 128 + v];
    const float vv = bf2f(zrow[ZV + h * 128 + v]); const float gzv = bf2f(zrow[ZG + h * 128 + v]);
    if (tid < 64) { const int j = tid; const float* wg = F.w_gate + (size_t)l * 16 * 256 + h * 64 + j; float ga = F.b_gate[l * 256 + h * 64 + j];
#pragma unroll
        for (int r = 0; r < 16; ++r) ga += F.alow[(size_t)row * 16 + r] * wg[r * 256];
        sA[j] = __expf(logsig(ga) * (1.0f / 16.0f)); sQ[j] = bf2f(zrow[ZQ + h * 64 + j]); sK[j] = bf2f(zrow[ZK + h * 64 + j]); }
    __syncthreads();
    float po = 0.f;
#pragma unroll 16
    for (int i = 0; i < 16; ++i) { const int k = kg * 16 + i; const float sn = sA[k] * s0r[i] + sK[k] * vv; Sn[k * 128 + v] = sn; po += sQ[k] * sn; }
    sO[kg * 128 + v] = po;
    __syncthreads();
    float o = 0.f;
    if (tid < 128) { o = 0.125f * ((sO[v] + sO[128 + v]) + (sO[256 + v] + sO[384 + v])); const float sq = wave_sum(o * o); if (F.lane == 0) sRed[F.wave] = sq; }
    __syncthreads();
    if (tid < 128) { const float rs = rsqrtf((sRed[0] + sRed[1]) * (1.0f / 128.0f) + EPS); const float gz = gzv;
        F.mix[(size_t)row * D + h * 128 + v] = f2bf(o * rs * F.gla_norm_g[l * 128 + v] * (gz / (1.f + __expf(-gz)))); }
    __syncthreads();
}
constexpr int L_U = 0, L_P = 40448;
struct PoolB { bf16x8 b[4][4]; float sc[4]; };
__device__ __forceinline__ void pool_load_b(const Frame& F, int l, int g, PoolB& P) {
    const int w = F.wave, fr = F.lane & 15, fq = F.lane >> 4, nt4 = (w & 1) * 4;
    const bf16_t* pw = wptr(F, l, W_POOL) + g * 16384;
#pragma unroll
    for (int q = 0; q < 4; ++q) {
#pragma unroll
        for (int ks = 0; ks < 4; ++ks) P.b[q][ks] = *(const bf16x8*)(pw + ((nt4 + q) * 16 + fr) * 128 + ks * 32 + fq * 8);
        P.sc[q] = F.pool_scale[l * 512 + g * 128 + (nt4 + q) * 16 + fr]; }
}
__device__ __forceinline__ void pool_mma_store(const Frame& F, int g, int row0, const PoolB& P) {
    LAS bf16_t* sP = (LAS bf16_t*)(F.lds + L_P);
    const int w = F.wave, fr = F.lane & 15, fq = F.lane >> 4, mt = w >> 1, nt4 = (w & 1) * 4;
    f32x4 acc[4];
#pragma unroll
    for (int q = 0; q < 4; ++q) acc[q] = (f32x4){0.f, 0.f, 0.f, 0.f};
#pragma unroll
    for (int ks = 0; ks < 4; ++ks) { const bf16x8 a = *(const LAS bf16x8*)(sP + (mt * 16 + fr) * 136 + ks * 32 + fq * 8);
#pragma unroll
        for (int q = 0; q < 4; ++q) acc[q] = __builtin_amdgcn_mfma_f32_16x16x32_bf16(a, P.b[q][ks], acc[q], 0, 0, 0); }
#pragma unroll
    for (int q = 0; q < 4; ++q) { const int d = (nt4 + q) * 16 + fr;
#pragma unroll
        for (int j = 0; j < 4; ++j) F.mix[(size_t)(row0 + mt * 16 + fq * 4 + j) * D + 512 + g * 128 + d] = f2bf(acc[q][j] * P.sc[q]); }
}
struct PoolU { u32x4 uv[3]; };
__device__ __forceinline__ void pool_prompt_load(const Frame& F, int unit, PoolU& U) {
    const int g = unit & 3, bn = unit >> 2, n = bn & 31, b = bn >> 5, t0 = n * 64, tid = F.tid, cg8 = tid & 15;
#pragma unroll
    for (int pass = 0; pass < 3; ++pass) { const int i = (tid >> 4) + pass * 32, t = t0 - 15 + i;
        U.uv[pass] = (u32x4){0u, 0u, 0u, 0u}; if (i < 79 && t >= 0) U.uv[pass] = *(const u32x4*)(F.z + (size_t)(b * SEQ + t) * ZLD + ZU + g * 128 + cg8 * 8); }
}
__device__ __forceinline__ void pool_prompt_unit(const Frame& F, int l, int unit, const PoolU& U, const PoolB& PB) {
    const int g = unit & 3, bn = unit >> 2, n = bn & 31, b = bn >> 5, t0 = n * 64, row0 = b * SEQ + t0, tid = F.tid;
    LAS float* sU = (LAS float*)(F.lds + L_U); LAS bf16_t* sP = (LAS bf16_t*)(F.lds + L_P);
    { const int cg8 = tid & 15;
#pragma unroll
      for (int pass = 0; pass < 3; ++pass) { const int i = (tid >> 4) + pass * 32; if (i < 79) {
          { const u32x4 uu = U.uv[pass]; *(LAS f32x4*)(sU + i * 128 + cg8 * 8) = (f32x4){bflo(uu.x), bfhi(uu.x), bflo(uu.y), bfhi(uu.y)}; *(LAS f32x4*)(sU + i * 128 + cg8 * 8 + 4) = (f32x4){bflo(uu.z), bfhi(uu.z), bflo(uu.w), bfhi(uu.w)}; } } } }
    __syncthreads();
    { const int c = tid & 127, tg = tid >> 7, wdw = 2 << g;
      float s = 0.f; const int i0 = tg * 16 + 15;
      for (int d = 1; d < wdw; ++d) s += sU[(i0 - d) * 128 + c];
#pragma unroll 4
      for (int tt = 0; tt < 16; ++tt) { const int i = i0 + tt; const float u = sU[i * 128 + c]; s += u; const int t = t0 + tg * 16 + tt; const float cnt = (float)min(wdw, t + 1);
          sP[(tg * 16 + tt) * 136 + c] = f2bf(s / cnt - u); s -= sU[(i - wdw + 1) * 128 + c]; }
      if (n == 31 && tid < 128) {
#pragma unroll
          for (int j = 0; j < 15; ++j) F.out[O_POOLP + (((size_t)l * 8 + b) * 15 + j) * 512 + g * 128 + c] = sU[(64 + j) * 128 + c]; } }
    __syncthreads();
    pool_mma_store(F, g, row0, PB);
    __syncthreads();
}
__device__ __forceinline__ void pool_sample_unit(const Frame& F, int l, int unit) {
    const int g = unit & 3, sblk = unit >> 2, tid = F.tid, c = tid & 127, sg = tid >> 7, wdw = 2 << g;
    LAS bf16_t* sP = (LAS bf16_t*)(F.lds + L_P);
    const int w = F.wave, fr = F.lane & 15, fq = F.lane >> 4;
    bf16x8 bfr[4];
    { const bf16_t* pw = wptr(F, l, W_POOL) + g * 16384;
#pragma unroll
      for (int ks = 0; ks < 4; ++ks) bfr[ks] = *(const bf16x8*)(pw + (w * 16 + fr) * 128 + ks * 32 + fq * 8); }
    const float sc = F.pool_scale[l * 512 + g * 128 + w * 16 + fr];
    float pv[4][15]; float uv[4];
#pragma unroll
    for (int i = 0; i < 4; ++i) { const int s = sblk * 16 + sg * 4 + i;
        const float* sp = F.state_pool + (((size_t)l * 128 + s) * 15) * 512 + g * 128 + c;
        uv[i] = bf2f(F.z[(size_t)(MP + s) * ZLD + ZU + g * 128 + c]);
#pragma unroll
        for (int j = 0; j < 15; ++j) pv[i][j] = sp[j * 512]; }
#pragma unroll
    for (int i = 0; i < 4; ++i) { const int sl = sg * 4 + i, s = sblk * 16 + sl;
        float* so = F.out + O_POOLS + (((size_t)l * 128 + s) * 15) * 512 + g * 128 + c;
        float sum = uv[i];
#pragma unroll
        for (int j = 0; j < 15; ++j) { if (j >= 16 - wdw) sum += pv[i][j]; if (j >= 1) so[(j - 1) * 512] = pv[i][j]; }
        so[14 * 512] = uv[i];
        sP[sl * 136 + c] = f2bf(sum / (float)wdw - uv[i]); }
    __syncthreads();
    f32x4 acc = (f32x4){0.f, 0.f, 0.f, 0.f};
#pragma unroll
    for (int ks = 0; ks < 4; ++ks) { const bf16x8 a = *(const LAS bf16x8*)(sP + fr * 136 + ks * 32 + fq * 8); acc = __builtin_amdgcn_mfma_f32_16x16x32_bf16(a, bfr[ks], acc, 0, 0, 0); }
#pragma unroll
    for (int j = 0; j < 4; ++j) F.mix[(size_t)(MP + sblk * 16 + fq * 4 + j) * D + 512 + g * 128 + w * 16 + fr] = f2bf(acc[j] * sc);
    __syncthreads();
}

__device__ __forceinline__ int gla_unit_at(int bid, int G, int k) { if (G != 256) return bid + k * G; const int b = bid & 7, j = bid >> 3; return ((b * 4 + (j & 3)) << 5) | ((j >> 2) * 4 + k); }
__device__ __forceinline__ int pool_unit_at(int bid, int G, int k) { if (G != 256) return bid + k * G; const int b = bid & 7, j = bid >> 3; return ((b * 32 + (j >> 2) * 4 + k) << 2) | (j & 3); }
__device__ __forceinline__ int units_of(int bid, int G) { return G == 256 ? 4 : (1024 - bid + G - 1) / G; }

__global__ void __launch_bounds__(512, 2) hymba_fwd(Args args) {
    extern __shared__ __attribute__((aligned(16))) unsigned char lds_raw[];
    cg::grid_group grid = cg::this_grid();
    typedef const __attribute__((address_space(4))) Args* KArgs;
    const KArgs ap0 = (KArgs)__builtin_amdgcn_kernarg_segment_ptr();
    const int ph_lo = ap0->ph_lo, ph_hi = ap0->ph_hi, coop = ap0->coop;
    for (int u = threadIdx.x; u < (LDS_BYTES - 131072) / 4; u += 512) ((LAS unsigned*)((LAS unsigned char*)lds_raw + 131072))[u] = 0u;
    __syncthreads();
    if (coop) (void)xcd_barrier_post((unsigned*)(ap0->ws + WS_CTL), (volatile LAS unsigned*)((LAS unsigned char*)lds_raw + MISC_OFF) + 8);
#ifndef PROBE_REP
#define PROBE_REP 0
#endif
    for (int ph = ph_lo; ph < ph_hi; ++ph) {
    const int sub_ = (ph == 0) ? -1 : (ph - 1) % 7; const int nrep = (ph == NPHASE - 1) ? 1 : ((ph == 0) ? ((PROBE_REP & 1) ? 2 : 1) : ((sub_ == 0 && (PROBE_REP & 2)) || (sub_ == 1 && (PROBE_REP & 4)) || (sub_ == 2 && (PROBE_REP & 8)) || (sub_ == 3 && (PROBE_REP & 16)) || (sub_ == 5 && (PROBE_REP & 32))) ? 2 : 1);
    for (int rep_ = 0; rep_ < nrep; ++rep_) {
    int tid_ = threadIdx.x; asm volatile("" : "+v"(tid_));
    KArgs ap = ap0; asm volatile("" : "+s"(ap));
    unsigned char* ws_ = ap->ws; float* out_ = ap->out;
    Frame F;
    F.lds = (LAS unsigned char*)lds_raw; F.tid = tid_; F.lane = F.tid & 63; F.wave = __builtin_amdgcn_readfirstlane(F.tid >> 6); F.G = gridDim.x; F.bid = blockIdx.x;
    F.x_prompt = ap->in[0]; F.x_sample = ap->in[1]; F.state_gla = ap->in[2]; F.state_pool = ap->in[3]; F.norm1_g = ap->in[4]; F.w_in = ap->in[5]; F.w_gate = ap->in[6]; F.b_gate = ap->in[7];
    F.gla_norm_g = ap->in[8]; F.pool_w = ap->in[9]; F.pool_scale = ap->in[10]; F.w_out = ap->in[11]; F.norm2_g = ap->in[12]; F.w_up = ap->in[13]; F.w_down = ap->in[14]; F.final_g = ap->in[15];
    F.out = out_; F.ws = ws_;
    F.rsp = (float*)(F.ws + WS_RSP); F.rss = (float*)(F.ws + WS_RSS); F.alow = (float*)(F.ws + WS_ALOW); F.dec = (float*)(F.ws + WS_DEC); F.kvt = (float*)(F.ws + WS_KVT);
    F.xb = (bf16_t*)(F.ws + WS_XB); F.z = (bf16_t*)(F.ws + WS_Z); F.mix = (bf16_t*)(F.ws + WS_MIX); F.hid = (bf16_t*)(F.ws + WS_HID); F.st = (bf16_t*)(F.ws + WS_ST);
    F.qt = (bf16_t*)(F.ws + WS_QKV); F.kt = F.qt + (size_t)1024 * 4096; F.vt = F.kt + (size_t)1024 * 4096;
        if (ph == 0) {
            p0_prologue(F);
        } else if (ph == NPHASE - 1) {
            const int gw = F.bid * 8 + F.wave, NGW = F.G * 8;
            for (int m = gw; m < MT; m += NGW) { const u32x2* xr = (const u32x2*)(F.xb + (size_t)m * D) + F.lane; f32x4* yo = (f32x4*)(F.out + (size_t)m * D) + F.lane; const f32x4* gr = (const f32x4*)F.final_g + F.lane;
                const float part = m < MP ? (F.lane < 16 ? F.rsp[((size_t)8 * MP + m) * 16 + F.lane] : 0.f) : F.rss[((size_t)8 * 128 + (m - MP)) * 64 + F.lane];
                const float rs = rsqrtf(wave_sum(part) * (1.0f / D) + EPS);
#pragma unroll
                for (int j = 0; j < 4; ++j) { const u32x2 xw = xr[64 * j]; f32x4 v = (f32x4){bflo(xw.x), bfhi(xw.x), bflo(xw.y), bfhi(xw.y)}; v = v * rs * gr[64 * j]; yo[64 * j] = v; } }
        } else {
            const int l = (ph - 1) / 7, sub = (ph - 1) % 7;
            if (sub == 0) {
                const float* ssp = F.rsp + (size_t)(2 * l) * MP * 16; const float* sss = F.rss + (size_t)(2 * l) * 128 * 64;
                { pg8::Gemm g{F.xb, wptr(F, l, W_IN), MP, ZLD, D}; pg8::StaticOrder S; S.init(MP, ZLD, F.G, F.bid);
                  pg8::EpiScaleBf16<0> E{F.z, ZLD, ssp};
                  pg8::gemm_phase<pg8::EpiScaleBf16<0>, pg8::StaticOrder, true, true>(F.lds, g, S, E, F.tid); }
                for (int u = F.bid; u < 129 + 128; u += F.G) {
                    if (u < 128) { SkAlow<16> E{F.alow + (size_t)u * 128 * 16, ssp + (size_t)u * 128 * 16}; skinny_unit<8, 2>(F.lds, F.xb + (size_t)u * 128 * D, D, wptr(F, l, W_IN) + (size_t)2048 * D, D, E, F.tid); }
                    else if (u == 128) { SkAlow<64> E{F.alow + (size_t)u * 128 * 16, sss}; skinny_unit<8, 2>(F.lds, F.xb + (size_t)u * 128 * D, D, wptr(F, l, W_IN) + (size_t)2048 * D, D, E, F.tid); }
                    else { const int j = u - 129; SkScaleBf16<0> E{F.z + (size_t)MP * ZLD + j * 16, ZLD, sss}; skinny_unit<8, 2>(F.lds, F.xb + (size_t)MP * D, D, wptr(F, l, W_IN) + (size_t)j * 16 * D, D, E, F.tid); }
                }
            } else if (sub == 1) {
                { KvC C; KvU U0; const int nu = units_of(F.bid, F.G);
                  const int u0 = gla_unit_at(min(F.bid, 1023), F.G, 0); gla_kv_loadc(F, l, (u0 >> 5) & 3, C); gla_kv_load(F, u0, U0);
                  for (int k = 0; k < nu; ++k) { const int u = gla_unit_at(F.bid, F.G, k); if (F.G != 256) gla_kv_loadc(F, l, (u >> 5) & 3, C);
                      KvU U1; if (k + 1 < nu) gla_kv_load(F, gla_unit_at(F.bid, F.G, k + 1), U1); else U1 = U0;
                      gla_kv_unit(F, l, u, C, U0); U0 = U1; } }
            } else if (sub == 2) {
                { PoolB PB; PoolU U0; const int nu = units_of(F.bid, F.G);
                  const int u0 = pool_unit_at(min(F.bid, 1023), F.G, 0); pool_load_b(F, l, u0 & 3, PB); pool_prompt_load(F, u0, U0);
                  gla_scan(F, l);
                  for (int k = 0; k < nu; ++k) { const int u = pool_unit_at(F.bid, F.G, k); if (F.G != 256) pool_load_b(F, l, u & 3, PB);
                      PoolU U1; if (k + 1 < nu) pool_prompt_load(F, pool_unit_at(F.bid, F.G, k + 1), U1); else U1 = U0;
                      pool_prompt_unit(F, l, u, U0, PB); U0 = U1; } }
                for (int u = 1024 + F.bid; u < 1024 + 32 + 512; u += F.G) {
                    if (u < 1056) pool_sample_unit(F, l, u - 1024); else gla_decode_unit(F, l, u - 1056);
                }
            } else if (sub == 3) {
                { OutU U0; float gnv[4];
#pragma unroll
                  for (int q = 0; q < 4; ++q) gnv[q] = F.gla_norm_g[l * 128 + ((F.wave & 1) * 4 + q) * 16 + (F.lane & 15)];
                  const int nu = units_of(F.bid, F.G); gla_out_load(F, gla_unit_at(min(F.bid, 1023), F.G, 0), U0);
                  for (int k = 0; k < nu; ++k) { const int u = gla_unit_at(F.bid, F.G, k); OutU U1; if (k + 1 < nu) gla_out_load(F, gla_unit_at(F.bid, F.G, k + 1), U1); else U1 = U0;
                      gla_out_unit_v3(F, l, u, U0, gnv); U0 = U1; } }
            } else if (sub == 4) {
                float* ssp = F.rsp + (size_t)(2 * l + 1) * MP * 16; float* sss = F.rss + (size_t)(2 * l + 1) * 128 * 64;
                { pg8::Gemm g{F.mix, wptr(F, l, W_OUT), MP, D, D}; pg8::StaticOrder S; S.init(MP, D, F.G, F.bid);
                  pg8::EpiRes E{F.xb, ssp};
                  pg8::gemm_phase<pg8::EpiRes, pg8::StaticOrder, true, true>(F.lds, g, S, E, F.tid); }
                for (int uu = F.bid; uu < 256; uu += F.G) { const int u = uu & 63, r0 = MP + (uu >> 6) * 32; SkRes E{F.xb + (size_t)r0 * D + u * 16, sss + (size_t)(r0 - MP) * 64, u}; skinny_unit<2, 4>(F.lds, F.mix + (size_t)r0 * D, D, wptr(F, l, W_OUT) + (size_t)u * 16 * D, D, E, F.tid); }
            } else if (sub == 5) {
                const float* ssp = F.rsp + (size_t)(2 * l + 1) * MP * 16; const float* sss = F.rss + (size_t)(2 * l + 1) * 128 * 64;
                { pg8::Gemm g{F.xb, wptr(F, l, W_UP), MP, FF, D}; pg8::StaticOrder S; S.init(MP, FF, F.G, F.bid);
                  pg8::EpiScaleBf16<1> E{F.hid, FF, ssp};
                  pg8::gemm_phase<pg8::EpiScaleBf16<1>, pg8::StaticOrder, true, true>(F.lds, g, S, E, F.tid); }
                for (int u = F.bid; u < 256; u += F.G) { SkScaleBf16<1> E{F.hid + (size_t)MP * FF + u * 16, FF, sss}; skinny_unit<8, 2>(F.lds, F.xb + (size_t)MP * D, D, wptr(F, l, W_UP) + (size_t)u * 16 * D, D, E, F.tid); }
            } else {
                float* ssp = F.rsp + (size_t)(2 * l + 2) * MP * 16; float* sss = F.rss + (size_t)(2 * l + 2) * 128 * 64;
                { pg8::Gemm g{F.hid, wptr(F, l, W_DOWN), MP, D, FF}; pg8::StaticOrder S; S.init(MP, D, F.G, F.bid);
                  pg8::EpiRes E{F.xb, ssp};
                  pg8::gemm_phase<pg8::EpiRes, pg8::StaticOrder, true, true>(F.lds, g, S, E, F.tid); }
                for (int uu = F.bid; uu < 256; uu += F.G) { const int u = uu & 63, r0 = MP + (uu >> 6) * 32; SkRes E{F.xb + (size_t)r0 * D + u * 16, sss + (size_t)(r0 - MP) * 64, u}; skinny_unit<2, 8>(F.lds, F.hid + (size_t)r0 * FF, FF, wptr(F, l, W_DOWN) + (size_t)u * 16 * FF, FF, E, F.tid); }
            }
        }
        }
        if (ph + 1 < ph_hi) { if (coop) { if (ph == 0) grid.sync(); else { KArgs apb = ap0; asm volatile("" : "+s"(apb)); XcdBarrier xbar; xbar.bar = (unsigned*)(apb->ws + WS_CTL); xbar.x = xb_xcc_id(); xbar.st = (volatile LAS unsigned*)((LAS unsigned char*)lds_raw + MISC_OFF) + 8; xcd_barrier(xbar); if (PROBE_REP & 64) xcd_barrier(xbar); } } }
    }
}

#ifndef ONE_LAUNCH
#define ONE_LAUNCH 1
#endif
extern "C" void kernel_launch(void* const* d_in, const int* in_sizes, int n_in, void* d_out, int out_size, void* d_ws, size_t ws_size, hipStream_t stream) {
    static int grid = 0;
    if (grid == 0) {
        if (n_in != 16 || ws_size < WS_END) { fprintf(stderr, "kernel_launch: need 16 inputs and >= %zu bytes of workspace (got %d, %zu)\n", (size_t)WS_END, n_in, ws_size); grid = -1; return; }
        int dev = 0, cus = 0, per_cu = 0;
        hipGetDevice(&dev); hipDeviceGetAttribute(&cus, hipDeviceAttributeMultiprocessorCount, dev);
        if (hipFuncSetAttribute((const void*)hymba_fwd, hipFuncAttributeMaxDynamicSharedMemorySize, LDS_BYTES) != hipSuccess) { fprintf(stderr, "kernel_launch: hipFuncSetAttribute failed\n"); grid = -1; return; }
        if (hipOccupancyMaxActiveBlocksPerMultiprocessor(&per_cu, (const void*)hymba_fwd, 512, LDS_BYTES) != hipSuccess || per_cu < 1) { fprintf(stderr, "kernel_launch: occupancy query says %d\n", per_cu); per_cu = 1; }
        (void)hipGetLastError();
        grid = cus;
    }
    if (grid < 0) return;
    if (hipMemsetAsync((char*)d_ws + WS_CTL, 0, CTL_ZERO_BYTES, stream) != hipSuccess) { fprintf(stderr, "kernel_launch: hipMemsetAsync failed\n"); return; }
    Args a{};
    for (int i = 0; i < 16; ++i) a.in[i] = (const float*)d_in[i];
    a.out = (float*)d_out; a.ws = (unsigned char*)d_ws;
#if ONE_LAUNCH
    a.ph_lo = 0; a.ph_hi = NPHASE; a.coop = 1;
    void* kargs[] = {&a};
    hipError_t e = hipLaunchCooperativeKernel((const void*)hymba_fwd, dim3(grid), dim3(512), kargs, LDS_BYTES, stream);
    if (e != hipSuccess) fprintf(stderr, "cooperative launch failed: %s (grid %d)\n", hipGetErrorString(e), grid);
#else
    for (int ph = 0; ph < NPHASE; ++ph) { a.ph_lo = ph; a.ph_hi = ph + 1; a.coop = 0; hipLaunchKernelGGL(hymba_fwd, dim3(grid), dim3(512), LDS_BYTES, stream, a); }
#endif
}
```

```cpp
#include <hip/hip_runtime.h>
#include <hip/hip_cooperative_groups.h>
#include <cstdio>
#include <cstdint>
namespace cg = cooperative_groups;

#define LAS __attribute__((address_space(3)))
typedef unsigned short bf16_t;
typedef short bf16x8 __attribute__((ext_vector_type(8)));
typedef float f32x4 __attribute__((ext_vector_type(4)));
typedef float f32x2 __attribute__((ext_vector_type(2)));
typedef __bf16 bf16x2n __attribute__((ext_vector_type(2)));
typedef unsigned u32x4 __attribute__((ext_vector_type(4)));
typedef unsigned u32x2 __attribute__((ext_vector_type(2)));

constexpr int D = 1024, SEQ = 2048, NBATCH = 8, MP = NBATCH * SEQ, MS = 128, MT = MP + MS, DEPTH = 4;
constexpr int FF = 4096, INW = 2064, ZLD = 2048;
constexpr float EPS = 1e-6f;
constexpr int ZQ = 0, ZK = 256, ZV = 512, ZG = 1024, ZU = 1536;
constexpr size_t O_GLAP = (size_t)MT * D, O_POOLP = O_GLAP + 4 * 8 * 4 * 64 * 128, O_GLAS = O_POOLP + 4 * 8 * 15 * 512, O_POOLS = O_GLAS + (size_t)4 * 128 * 4 * 64 * 128;
constexpr size_t MiB = 1u << 20;
constexpr size_t WS_ALOW = 1 * MiB, WS_DEC = 3 * MiB, WS_W = 4 * MiB, W_STRIDE = 23 * MiB;
constexpr size_t W_IN = 0, W_OUT = 4 * MiB + 512 * 1024, W_UP = W_OUT + 2 * MiB, W_DOWN = W_UP + 8 * MiB, W_POOL = W_DOWN + 8 * MiB;
constexpr size_t WS_XB = 96 * MiB, WS_Z = 129 * MiB, WS_MIX = 194 * MiB, WS_HID = 129 * MiB, WS_KVT = 227 * MiB, WS_ST = 259 * MiB, WS_RSP = 275 * MiB, WS_RSS = 284 * MiB, WS_QKV = 285 * MiB, WS_END = 317 * MiB;
static_assert(W_POOL + 128 * 1024 <= W_STRIDE && WS_W + 4 * W_STRIDE <= WS_XB, "weight map");
constexpr int LDS_BYTES = 147456, MISC_OFF = 131072 + 320;
constexpr size_t WS_CTL = 0, CTL_ZERO_BYTES = 16384;
constexpr int NPHASE = 2 + 7 * DEPTH;

__device__ __forceinline__ unsigned cvtpk(float lo, float hi) { f32x2 v = {lo, hi}; bf16x2n b = __builtin_convertvector(v, bf16x2n); return __builtin_bit_cast(unsigned, b); }
__device__ __forceinline__ bf16_t f2bf(float f) { return (bf16_t)(cvtpk(f, 0.f) & 0xffffu); }
__device__ __forceinline__ float bf2f(bf16_t h) { return __uint_as_float((unsigned)h << 16); }
__device__ __forceinline__ float bflo(unsigned w) { return __uint_as_float(w << 16); }
__device__ __forceinline__ float bfhi(unsigned w) { return __uint_as_float(w & 0xffff0000u); }
__device__ __forceinline__ float wave_sum(float v) {
#pragma unroll
    for (int o = 1; o < 64; o <<= 1) v += __shfl_xor(v, o);
    return v;
}
#define LDS_WAIT() asm volatile("s_waitcnt lgkmcnt(0)" ::: "memory")

namespace pg8 {
constexpr int BM = 256, BK = 64, HALF = 128, HTB = HALF * BK * 2, STAGE_BYTES = 8 * HTB, NXCD = 8, WGM = 8;
__host__ __device__ __forceinline__ int lds_byte(int r, int c) { const int st = (r >> 4) * 2 + (c >> 5), rr = r & 15, cc = c & 31, ob = rr * 64 + cc * 2; return st * 1024 + (ob ^ (((ob >> 9) & 1) << 5)); }
__host__ __device__ __forceinline__ void stage_rc(int b, int& R, int& C) { const int st = b / 1024, sb = b % 1024, swz = sb ^ (((sb >> 9) & 1) << 5); R = (st >> 1) * 16 + swz / 64; C = (st & 1) * 32 + (swz % 64) / 2; }
__host__ __device__ __forceinline__ int perm32(int rho) { const int n = rho >> 4, i = rho & 15; return 8 * (i >> 2) + 4 * n + (i & 3); }
struct Unit { int pm, pn; };
struct Gemm { const bf16_t* A; const bf16_t* Bt; int M, N, K; };
struct StaticOrder {
    int nM, nN, nwg, G, c;
    __host__ __device__ void init(int M, int N, int G_, int c_) { nM = M / BM; nN = N / BM; nwg = nM * nN; G = G_; c = c_; }
    __host__ __device__ bool next(int i, Unit& u) const {
        const long L = (long)i * G + c; if (L >= nwg) return false;
        int wgid = (int)L; { const int q = nwg / NXCD, r = nwg % NXCD, xcd = wgid % NXCD, off = wgid / NXCD; wgid = (xcd < r ? xcd * (q + 1) : r * (q + 1) + (xcd - r) * q) + off; }
        const int nig = WGM * nN, gid = wgid / nig, fm = gid * WGM, gsz = (nM - fm) < WGM ? (nM - fm) : WGM;
        u.pm = fm + ((wgid % nig) % gsz); u.pn = (wgid % nig) / gsz; return true;
    }
    __device__ __forceinline__ void a_ready(const Unit&) const {}
    __device__ __forceinline__ void done(const Unit&) const {}
};

template <int ACT> struct EpiScaleBf16 {
    static constexpr bool PERM = true, AFTER_DRAIN = false;
    bf16_t* O; int ldc; const float* rowss;
    __device__ __forceinline__ void operator()(const f32x4 (&acc)[2][2][4][2], const Unit& u, int wr, int wc, int fr, int fq) const {
        const int row0 = u.pm * BM + wr * 64 + fr; const int col0 = u.pn * BM + wc * 32 + 8 * fq;
#pragma unroll
        for (int ai = 0; ai < 2; ++ai)
#pragma unroll
            for (int m = 0; m < 4; ++m) {
                const int row = row0 + ai * HALF + m * 16;
                const f32x4 s0 = *(const f32x4*)(rowss + (size_t)row * 16 + fq * 4);
                float tot = (s0[0] + s0[1]) + (s0[2] + s0[3]); tot += __shfl_xor(tot, 16); tot += __shfl_xor(tot, 32);
                const float rs = rsqrtf(tot * (1.0f / D) + EPS);
                bf16_t* rowp = O + (size_t)row * ldc + col0;
#pragma unroll
                for (int bj = 0; bj < 2; ++bj) {
                    f32x4 v0 = acc[ai][bj][m][0] * rs, v1 = acc[ai][bj][m][1] * rs;
                    if (ACT == 1) {
#pragma unroll
                        for (int e = 0; e < 4; ++e) { const float a = fmaxf(v0[e], 0.f), b = fmaxf(v1[e], 0.f); v0[e] = a * a; v1[e] = b * b; }
                    }
                    u32x4 w; w.x = cvtpk(v0[0], v0[1]); w.y = cvtpk(v0[2], v0[3]); w.z = cvtpk(v1[0], v1[1]); w.w = cvtpk(v1[2], v1[3]);
                    *(u32x4*)(rowp + bj * HALF) = w;
                }
            }
    }
};
struct EpiRes {
    static constexpr bool PERM = true, AFTER_DRAIN = false;
    bf16_t* XB; float* ssout;
    __device__ __forceinline__ void operator()(const f32x4 (&acc)[2][2][4][2], const Unit& u, int wr, int wc, int fr, int fq) const {
        const int row0 = u.pm * BM + wr * 64 + fr; const int col0 = u.pn * BM + wc * 32 + 8 * fq;
#pragma unroll
        for (int ai = 0; ai < 2; ++ai)
#pragma unroll
            for (int m = 0; m < 4; ++m) {
                const int row = row0 + ai * HALF + m * 16;
                bf16_t* br = XB + (size_t)row * D + col0;
                float ss = 0.f;
#pragma unroll
                for (int bj = 0; bj < 2; ++bj) {
                    const u32x4 xo = *(const u32x4*)(br + bj * HALF);
                    const f32x4 a0 = acc[ai][bj][m][0], a1 = acc[ai][bj][m][1];
                    u32x4 w; w.x = cvtpk(bflo(xo.x) + a0[0], bfhi(xo.x) + a0[1]); w.y = cvtpk(bflo(xo.y) + a0[2], bfhi(xo.y) + a0[3]);
                    w.z = cvtpk(bflo(xo.z) + a1[0], bfhi(xo.z) + a1[1]); w.w = cvtpk(bflo(xo.w) + a1[2], bfhi(xo.w) + a1[3]);
                    *(u32x4*)(br + bj * HALF) = w;
#pragma unroll
                    for (int e = 0; e < 4; ++e) { const float lo = bflo(w[e]), hi = bfhi(w[e]); ss += lo * lo + hi * hi; }
                }
                ss += __shfl_xor(ss, 16); ss += __shfl_xor(ss, 32);
                if (fq == 0) ssout[(size_t)row * 16 + u.pn * 4 + wc] = ss;
            }
    }
};
template <class Epi, class Sched, bool ALIGN_EPI = false, bool SP2 = false>
__device__ __forceinline__ void gemm_phase(LAS unsigned char* lds, const Gemm g, const Sched& S, const Epi& E, const int tid) {
    const int wid = __builtin_amdgcn_readfirstlane(tid >> 6), lane = tid & 63, wr = wid >> 2, wc = wid & 3, fr = lane & 15, fq = lane >> 4;
    const int K = g.K, nt = K / BK;
    unsigned voffA[2], voffB[2];
#pragma unroll
    for (int i = 0; i < 2; ++i) { int R, C; stage_rc(tid * 16 + i * 8192, R, C); const int Rb = Epi::PERM ? ((R & ~31) + perm32(R & 31)) : R;
        voffA[i] = (unsigned)(R * K + C) * 2u; voffB[i] = (unsigned)(Rb * K + C) * 2u; }
    const size_t kstep = (size_t)(BK * 2);
    const size_t hstep = (size_t)HALF * K * 2;
    const size_t tstep = 2 * hstep;
    const unsigned ldsw = (unsigned)wid * 1024u;
    const int aoff = lds_byte(wr * 64 + fr, fq * 8), boff = lds_byte(wc * 32 + fr, fq * 8);
#define PG8_SA(b, h) (((b) * 2 + (h)) * HTB)
#define PG8_SB(b, h) ((4 + (b) * 2 + (h)) * HTB)
#define PG8_STAGE(bufoff, gbase, voff) do { _Pragma("unroll") for (int _i = 0; _i < 2; ++_i) \
        __builtin_amdgcn_global_load_lds((const unsigned*)((const char*)(gbase) + (voff)[_i]), (LAS unsigned*)(lds + (bufoff) + ldsw + _i * 8192), 16, 0, 0); } while (0)
#define PG8_LDA(dst, b, h) do { _Pragma("unroll") for (int m = 0; m < 4; ++m) _Pragma("unroll") for (int k = 0; k < 2; ++k) dst[m][k] = *(const LAS bf16x8*)(lds + PG8_SA(b, h) + aoff + m * 2048 + k * 1024); } while (0)
#define PG8_LDB(dst, b, h) do { _Pragma("unroll") for (int n = 0; n < 2; ++n) _Pragma("unroll") for (int k = 0; k < 2; ++k) dst[n][k] = *(const LAS bf16x8*)(lds + PG8_SB(b, h) + boff + n * 2048 + k * 1024); } while (0)
#define PG8_MMA(ai, bj, At, Bt) do { __builtin_amdgcn_s_setprio(1); _Pragma("unroll") for (int m = 0; m < 4; ++m) _Pragma("unroll") for (int n = 0; n < 2; ++n) _Pragma("unroll") for (int k = 0; k < 2; ++k) \
        acc[ai][bj][m][n] = __builtin_amdgcn_mfma_f32_16x16x32_bf16(Bt[n][k], At[m][k], acc[ai][bj][m][n], 0, 0, 0); __builtin_amdgcn_s_setprio(0); } while (0)
#define PG8_WAIT_V(n) asm volatile("s_waitcnt vmcnt(" #n ")" ::: "memory")
#define PG8_WAIT_L(n) asm volatile("s_waitcnt lgkmcnt(" #n ")" ::: "memory")
#define PG8_BAR __builtin_amdgcn_s_barrier()
#define PG8_SCHED __builtin_amdgcn_sched_barrier(0)
    Unit cur, nxt; int ui = 0;
    if (!S.next(0, cur)) return;
    f32x4 acc[2][2][4][2];
#pragma unroll
    for (int a = 0; a < 2; ++a)
#pragma unroll
        for (int b = 0; b < 2; ++b)
#pragma unroll
            for (int m = 0; m < 4; ++m)
#pragma unroll
                for (int n = 0; n < 2; ++n) acc[a][b][m][n] = (f32x4){0.f, 0.f, 0.f, 0.f};
    bf16x8 At[4][2], B0[2][2], B1[2][2];
    const char* cA = (const char*)g.A + (size_t)cur.pm * tstep; const char* cB = (const char*)g.Bt + (size_t)cur.pn * tstep;
    S.a_ready(cur);
    if constexpr (SP2) {
        PG8_STAGE(PG8_SB(0, 0), cB, voffB); PG8_STAGE(PG8_SB(0, 1), cB + hstep, voffB); PG8_STAGE(PG8_SA(0, 0), cA, voffA); PG8_STAGE(PG8_SA(0, 1), cA + hstep, voffA);
        if (wr == 1) PG8_BAR;
        PG8_WAIT_V(2); PG8_BAR;
        PG8_STAGE(PG8_SB(1, 0), cB + kstep, voffB); PG8_STAGE(PG8_SA(1, 0), cA + kstep, voffA); PG8_STAGE(PG8_SB(1, 1), cB + hstep + kstep, voffB);
        PG8_WAIT_V(6); PG8_BAR;
    } else {
        PG8_STAGE(PG8_SB(0, 0), cB, voffB); PG8_STAGE(PG8_SA(0, 0), cA, voffA); PG8_STAGE(PG8_SB(0, 1), cB + hstep, voffB); PG8_STAGE(PG8_SA(0, 1), cA + hstep, voffA);
        if (wr == 1) PG8_BAR;
        PG8_WAIT_V(4); PG8_BAR;
        PG8_STAGE(PG8_SB(1, 0), cB + kstep, voffB); PG8_STAGE(PG8_SA(1, 0), cA + kstep, voffA); PG8_STAGE(PG8_SB(1, 1), cB + hstep + kstep, voffB);
        PG8_WAIT_V(6); PG8_BAR;
    }
    for (;;) {
        const bool has_next = S.next(ui + 1, nxt);
        const char* nA = has_next ? (const char*)g.A + (size_t)nxt.pm * tstep : cA; const char* nB = has_next ? (const char*)g.Bt + (size_t)nxt.pn * tstep : cB;
        for (int t = 0; t < nt; t += 2) {
            const bool last = (t == nt - 2);
            const char* a1 = cA + (size_t)(t + 1) * kstep;
            const char* a2 = last ? nA : cA + (size_t)(t + 2) * kstep; const char* b2 = last ? nB : cB + (size_t)(t + 2) * kstep;
            const char* a3 = a2 + kstep; const char* b3 = b2 + kstep;
            if (last && has_next) S.a_ready(nxt);
            if constexpr (SP2) {
            PG8_LDB(B0, 0, 0); PG8_LDB(B1, 0, 1); PG8_SCHED; PG8_LDA(At, 0, 0); PG8_STAGE(PG8_SA(1, 1), a1 + hstep, voffA);
            PG8_WAIT_V(8); PG8_WAIT_L(0); PG8_BAR; PG8_MMA(0, 0, At, B0); PG8_MMA(0, 1, At, B1); PG8_BAR; PG8_SCHED;
            PG8_LDA(At, 0, 1); PG8_STAGE(PG8_SB(0, 0), b2, voffB); PG8_STAGE(PG8_SB(0, 1), b2 + hstep, voffB); PG8_STAGE(PG8_SA(0, 0), a2, voffA);
            PG8_WAIT_V(8); PG8_WAIT_L(0); PG8_BAR; PG8_MMA(1, 0, At, B0); PG8_MMA(1, 1, At, B1); PG8_BAR; PG8_SCHED;
            PG8_LDB(B0, 1, 0); PG8_LDB(B1, 1, 1); PG8_SCHED; PG8_LDA(At, 1, 0); PG8_STAGE(PG8_SA(0, 1), a2 + hstep, voffA);
            PG8_WAIT_V(8); PG8_WAIT_L(0); PG8_BAR; PG8_MMA(0, 0, At, B0); PG8_MMA(0, 1, At, B1); PG8_BAR; PG8_SCHED;
            PG8_LDA(At, 1, 1); PG8_STAGE(PG8_SB(1, 0), b3, voffB); PG8_STAGE(PG8_SB(1, 1), b3 + hstep, voffB); PG8_STAGE(PG8_SA(1, 0), a3, voffA);
            PG8_WAIT_V(8); PG8_WAIT_L(0); PG8_BAR; PG8_MMA(1, 0, At, B0); PG8_MMA(1, 1, At, B1); PG8_BAR; PG8_SCHED;
            } else {
            PG8_LDB(B0, 0, 0); PG8_SCHED; PG8_LDA(At, 0, 0); PG8_STAGE(PG8_SA(1, 1), a1 + hstep, voffA);
            PG8_WAIT_L(8); PG8_BAR; PG8_WAIT_L(0); PG8_MMA(0, 0, At, B0); PG8_BAR; PG8_SCHED;
            PG8_LDB(B1, 0, 1); PG8_STAGE(PG8_SB(0, 0), b2, voffB);
            PG8_BAR; PG8_WAIT_L(0); PG8_MMA(0, 1, At, B1); PG8_BAR;
            PG8_LDA(At, 0, 1); PG8_STAGE(PG8_SA(0, 0), a2, voffA);
            PG8_BAR; PG8_WAIT_L(0); PG8_MMA(1, 0, At, B0); PG8_BAR; PG8_SCHED;
            PG8_STAGE(PG8_SB(0, 1), b2 + hstep, voffB);
            PG8_WAIT_V(6); PG8_BAR; PG8_MMA(1, 1, At, B1); PG8_BAR;
            PG8_LDB(B0, 1, 0); PG8_SCHED; PG8_LDA(At, 1, 0); PG8_STAGE(PG8_SA(0, 1), a2 + hstep, voffA);
            PG8_WAIT_L(8); PG8_BAR; PG8_WAIT_L(0); PG8_MMA(0, 0, At, B0); PG8_BAR; PG8_SCHED;
            PG8_LDB(B1, 1, 1); PG8_STAGE(PG8_SB(1, 0), b3, voffB);
            PG8_BAR; PG8_WAIT_L(0); PG8_MMA(0, 1, At, B1); PG8_BAR;
            PG8_LDA(At, 1, 1); PG8_STAGE(PG8_SA(1, 0), a3, voffA);
            PG8_BAR; PG8_WAIT_L(0); PG8_MMA(1, 0, At, B0); PG8_BAR; PG8_SCHED;
            PG8_STAGE(PG8_SB(1, 1), b3 + hstep, voffB);
            PG8_WAIT_V(6); PG8_BAR; PG8_MMA(1, 1, At, B1); PG8_BAR;
            }
        }
        if constexpr (ALIGN_EPI) { if (wr == 0) PG8_BAR; }
        if constexpr (!Epi::AFTER_DRAIN) { E(acc, cur, wr, wc, fr, fq); S.done(cur); }
        if (!has_next) break;
#pragma unroll
        for (int a = 0; a < 2; ++a)
#pragma unroll
            for (int b = 0; b < 2; ++b)
#pragma unroll
                for (int m = 0; m < 4; ++m)
#pragma unroll
                    for (int n = 0; n < 2; ++n) acc[a][b][m][n] = (f32x4){0.f, 0.f, 0.f, 0.f};
        cur = nxt; cA = nA; cB = nB; ++ui;
        if constexpr (ALIGN_EPI) { if (wr == 1) PG8_BAR; }
    }
    PG8_WAIT_V(0);
    if constexpr (!ALIGN_EPI) { if (wr == 0) PG8_BAR; }
    PG8_BAR;
#undef PG8_SA
#undef PG8_SB
#undef PG8_STAGE
#undef PG8_LDA
#undef PG8_LDB
#undef PG8_MMA
#undef PG8_WAIT_V
#undef PG8_WAIT_L
#undef PG8_BAR
#undef PG8_SCHED
}
}

template <int MTN, int UNR, class Epi>
__device__ __forceinline__ void skinny_unit(LAS unsigned char* lds, const bf16_t* A, int lda, const bf16_t* Bt, int K, const Epi& E, const int tid) {
    const int wid = __builtin_amdgcn_readfirstlane(tid >> 6), lane = tid & 63, fr = lane & 15, fq = lane >> 4;
    const int kw = K / 8, k0 = wid * kw;
    f32x4 acc[MTN];
#pragma unroll
    for (int m = 0; m < MTN; ++m) acc[m] = (f32x4){0.f, 0.f, 0.f, 0.f};
    const bf16_t* ap = A + (size_t)fr * lda + k0 + fq * 8;
    const bf16_t* bp = Bt + (size_t)fr * K + k0 + fq * 8;
    for (int ks = 0; ks < kw; ks += 32 * UNR) {
        bf16x8 b[UNR], a[UNR][MTN];
#pragma unroll
        for (int u = 0; u < UNR; ++u) { b[u] = *(const bf16x8*)(bp + ks + u * 32);
#pragma unroll
            for (int m = 0; m < MTN; ++m) a[u][m] = *(const bf16x8*)(ap + (size_t)(m * 16) * lda + ks + u * 32); }
#pragma unroll
        for (int u = 0; u < UNR; ++u)
#pragma unroll
            for (int m = 0; m < MTN; ++m) acc[m] = __builtin_amdgcn_mfma_f32_16x16x32_bf16(a[u][m], b[u], acc[m], 0, 0, 0);
    }
    constexpr int ROWS = MTN * 16;
    LAS float* part = (LAS float*)lds;
#pragma unroll
    for (int m = 0; m < MTN; ++m)
#pragma unroll
        for (int j = 0; j < 4; ++j) part[(wid * ROWS + m * 16 + fq * 4 + j) * 16 + fr] = acc[m][j];
    __syncthreads();
    if (tid < ROWS * 4) {
        const int row = tid >> 2, c4 = (tid & 3) * 4;
        f32x4 s = (f32x4){0.f, 0.f, 0.f, 0.f};
#pragma unroll
        for (int w = 0; w < 8; ++w) s = s + *(const LAS f32x4*)(part + (w * ROWS + row) * 16 + c4);
        E(row, c4, s, tid);
    }
    __syncthreads();
}
template <int NS> __device__ __forceinline__ float sk_rstd(const float* base, int row, int tid) {
    const f32x4* p = (const f32x4*)(base + (size_t)row * NS + (tid & 3) * (NS / 4)); float s = 0.f;
#pragma unroll
    for (int i = 0; i < NS / 16; ++i) { const f32x4 v = p[i]; s += (v[0] + v[1]) + (v[2] + v[3]); }
    s += __shfl_xor(s, 1); s += __shfl_xor(s, 2);
    return rsqrtf(s * (1.0f / D) + EPS);
}
template <int NS> struct SkAlow { float* O; const float* rowss; __device__ __forceinline__ void operator()(int row, int c4, f32x4 v, int tid) const {
    const float rs = sk_rstd<NS>(rowss, row, tid); *(f32x4*)(O + (size_t)row * 16 + c4) = v * rs; } };
template <int ACT> struct SkScaleBf16 { bf16_t* O; int ldc; const float* rowss; __device__ __forceinline__ void operator()(int row, int c4, f32x4 v, int tid) const {
    const float rs = sk_rstd<64>(rowss, row, tid); v = v * rs;
    if (ACT == 1) {
#pragma unroll
        for (int e = 0; e < 4; ++e) { const float a = fmaxf(v[e], 0.f); v[e] = a * a; } }
    u32x2 w; w.x = cvtpk(v[0], v[1]); w.y = cvtpk(v[2], v[3]); *(u32x2*)(O + (size_t)row * ldc + c4) = w; } };
struct SkRes { bf16_t* XB; float* ssout; int slot; __device__ __forceinline__ void operator()(int row, int c4, f32x4 v, int tid) const {
    const u32x2 xo = *(const u32x2*)(XB + (size_t)row * D + c4);
    u32x2 w; w.x = cvtpk(bflo(xo.x) + v[0], bfhi(xo.x) + v[1]); w.y = cvtpk(bflo(xo.y) + v[2], bfhi(xo.y) + v[3]); *(u32x2*)(XB + (size_t)row * D + c4) = w;
    float ss = (bflo(w.x) * bflo(w.x) + bfhi(w.x) * bfhi(w.x)) + (bflo(w.y) * bflo(w.y) + bfhi(w.y) * bfhi(w.y)); ss += __shfl_xor(ss, 1); ss += __shfl_xor(ss, 2);
    if ((tid & 3) == 0) ssout[(size_t)row * 64 + slot] = ss; } };

#define XB_TMO      128
#define XB_XCNT(j)  (256  + 64 * (j))
#define XB_XSUB(j)  (1280 + 64 * (j))
#define XB_XGEN(j)  (2304 + 64 * (j))
#define XB_TOP      3328
#define XB_TOPGEN   3392
#define XCD_BAR_WORDS 3456
#define XB_SPIN_CAP (1u << 18)
__device__ __forceinline__ unsigned xb_ld(unsigned* p)              { return __hip_atomic_load(p, __ATOMIC_RELAXED, __HIP_MEMORY_SCOPE_AGENT); }
__device__ __forceinline__ unsigned xb_add(unsigned* p, unsigned v) { return __hip_atomic_fetch_add(p, v, __ATOMIC_RELAXED, __HIP_MEMORY_SCOPE_AGENT); }
__device__ __forceinline__ unsigned xb_xcc_id() { return (unsigned)__builtin_amdgcn_s_getreg((3 << 11) | 20) & 0xFu; }
#define XB_SPIN(cond, bar) do { unsigned _sp = 0; while (cond) { __builtin_amdgcn_s_sleep(1); \
    if ((++_sp & 255u) == 0u) { if (xb_ld(&(bar)[XB_TMO])) break; if (_sp > XB_SPIN_CAP) { atomicAdd(&(bar)[XB_TMO], 1u); break; } } } } while (0)
struct XcdBarrier { unsigned* bar; unsigned x; volatile LAS unsigned* st; };
__device__ __forceinline__ XcdBarrier xcd_barrier_post(unsigned* bar, volatile LAS unsigned* st) {
    XcdBarrier b; b.bar = bar; b.x = xb_xcc_id(); b.st = st;
    if (threadIdx.x == 0) (void)xb_add(&bar[XB_XCNT(b.x)], 1u);
    return b;
}
__device__ __forceinline__ void xcd_barrier_complete(unsigned* bar, unsigned x, unsigned& nloc, unsigned& nx) {
    const unsigned G = gridDim.x * gridDim.y * gridDim.z;
    unsigned sum, cnt, mine, sp = 0u;
    for (;;) {
        sum = 0u; cnt = 0u; mine = 0u;
#pragma unroll
        for (unsigned j = 0; j < 16; ++j) { const unsigned c = xb_ld(&bar[XB_XCNT(j)]); sum += c; cnt += (c > 0u) ? 1u : 0u; mine = (j == x) ? c : mine; }
        if (sum == G) break;
        __builtin_amdgcn_s_sleep(1);
        if ((++sp & 255u) == 0u) { if (xb_ld(&bar[XB_TMO])) break; if (sp > XB_SPIN_CAP) { atomicAdd(&bar[XB_TMO], 1u); break; } }
    }
    nloc = mine > 0u ? mine : 1u; nx = cnt > 0u ? cnt : 1u;
}
__device__ __forceinline__ void xcd_barrier(const XcdBarrier& b) {
    asm volatile("s_waitcnt vmcnt(0)" ::: "memory");
    __syncthreads();
    if (threadIdx.x == 0) {
        unsigned* bar = b.bar;
        __builtin_amdgcn_s_waitcnt(0);
        unsigned nloc = b.st[0], nx = b.st[1];
        if (nloc == 0u) { xcd_barrier_complete(bar, b.x, nloc, nx); b.st[0] = nloc; b.st[1] = nx; }
        const unsigned old = xb_add(&bar[XB_XSUB(b.x)], 1u);
        const unsigned gen = old / nloc;
        if (old + 1u == (gen + 1u) * nloc) {
            __builtin_amdgcn_fence(__ATOMIC_RELEASE, "agent");
            asm volatile("s_waitcnt vmcnt(0)" ::: "memory");
            const unsigned og = xb_add(&bar[XB_TOP], 1u);
            const unsigned tg = og / nx;
            __builtin_amdgcn_fence(__ATOMIC_ACQUIRE, "");
            if (og + 1u == (tg + 1u) * nx) xb_add(&bar[XB_TOPGEN], 1u);
            else XB_SPIN(xb_ld(&bar[XB_TOPGEN]) == tg, bar);
            xb_add(&bar[XB_XGEN(b.x)], 1u);
            asm volatile("s_waitcnt vmcnt(0)" ::: "memory");
        } else {
            __builtin_amdgcn_fence(__ATOMIC_ACQUIRE, "");
            XB_SPIN(xb_ld(&bar[XB_XGEN(b.x)]) == gen, bar);
            asm volatile("s_waitcnt vmcnt(0)" ::: "memory");
        }
    }
    __syncthreads();
}

struct Args { const float* in[16]; float* out; unsigned char* ws; int ph_lo, ph_hi, coop, pad; };
struct Frame {
    LAS unsigned char* lds; int tid, lane, wave, G, bid;
    const float *x_prompt, *x_sample, *state_gla, *state_pool, *norm1_g, *w_in, *w_gate, *b_gate, *gla_norm_g, *pool_w, *pool_scale, *w_out, *norm2_g, *w_up, *w_down, *final_g;
    float* out; unsigned char* ws;
    float *rsp, *rss, *alow, *dec, *kvt; bf16_t *xb, *z, *mix, *hid, *st, *qt, *kt, *vt;
};
__device__ __forceinline__ bf16_t* wptr(const Frame& F, int l, size_t off) { return (bf16_t*)(F.ws + WS_W + (size_t)l * W_STRIDE + off); }

struct TItem { const float* W; bf16_t* WT; const float* kscale; int ldw, K, k0, nsrc0, ndst0, nvalid; };
struct TRegs { f32x4 v[8]; float ks[8]; };
__device__ __forceinline__ void titem_decode(const Frame& F, int it, TItem& T) {
    constexpr int I_IN = 16 * 65, I_OUT = 16 * 32, I_UP = 16 * 128, I_DOWN = 64 * 32, I_POOL = 32, I_LAYER = I_IN + I_OUT + I_UP + I_DOWN + I_POOL;
    const int l = it / I_LAYER; int r = it % I_LAYER;
    if (r < I_IN) { const int kb = r / 65, nb = r % 65, nd = nb * 32;
        T = TItem{F.w_in + (size_t)l * D * INW, wptr(F, l, W_IN), F.norm1_g + l * D, INW, D, kb * 64, nd < 1536 ? nd : (nd < 2048 ? nd + 16 : 1536), nd, nd < 2048 ? 32 : 16}; return; } r -= I_IN;
    if (r < I_OUT) { const int kb = r / 32, nb = r % 32; T = TItem{F.w_out + (size_t)l * D * D, wptr(F, l, W_OUT), nullptr, D, D, kb * 64, nb * 32, nb * 32, 32}; return; } r -= I_OUT;
    if (r < I_UP) { const int kb = r / 128, nb = r % 128; T = TItem{F.w_up + (size_t)l * D * FF, wptr(F, l, W_UP), F.norm2_g + l * D, FF, D, kb * 64, nb * 32, nb * 32, 32}; return; } r -= I_UP;
    if (r < I_DOWN) { const int kb = r / 32, nb = r % 32; T = TItem{F.w_down + (size_t)l * FF * D, wptr(F, l, W_DOWN), nullptr, D, FF, kb * 64, nb * 32, nb * 32, 32}; return; } r -= I_DOWN;
    { const int g = r / 8, kb = (r % 8) / 4, nb = r % 4; T = TItem{F.pool_w + ((size_t)l * 4 + g) * 128 * 128, wptr(F, l, W_POOL) + g * 16384, nullptr, 128, 128, kb * 64, nb * 32, nb * 32, 32}; }
}
__device__ __forceinline__ void titem_load(const TItem& T, TRegs& R, int lane) {
    const int c4 = (lane & 7) * 4, kr = lane >> 3;
#pragma unroll
    for (int i = 0; i < 8; ++i) { const int kk = 8 * i + kr; R.v[i] = (c4 < T.nvalid) ? *(const f32x4*)(T.W + (size_t)(T.k0 + kk) * T.ldw + T.nsrc0 + c4) : (f32x4){0.f, 0.f, 0.f, 0.f}; R.ks[i] = T.kscale ? T.kscale[T.k0 + kk] : 1.0f; }
}
__device__ __forceinline__ void titem_store(const TItem& T, const TRegs& R, LAS float* scr, int lane) {
    const int c4 = (lane & 7) * 4, kr = lane >> 3;
#pragma unroll
    for (int i = 0; i < 8; ++i) { const int kk = 8 * i + kr;
#pragma unroll
        for (int e = 0; e < 4; ++e) scr[kk * 33 + c4 + e] = R.v[i][e] * R.ks[i]; }
    LDS_WAIT(); asm volatile("" ::: "memory");
    const int c8 = lane & 7;
#pragma unroll
    for (int j = 0; j < 4; ++j) { const int n = (lane >> 3) + 8 * j; const LAS float* s = scr + (8 * c8) * 33 + n;
        u32x4 o; o.x = cvtpk(s[0 * 33], s[1 * 33]); o.y = cvtpk(s[2 * 33], s[3 * 33]); o.z = cvtpk(s[4 * 33], s[5 * 33]); o.w = cvtpk(s[6 * 33], s[7 * 33]);
        if (n < T.nvalid) *(u32x4*)(T.WT + (size_t)(T.ndst0 + n) * T.K + T.k0 + 8 * c8) = o; }
    LDS_WAIT(); asm volatile("" ::: "memory");
}
__device__ __forceinline__ void p0_prologue(Frame& F) {
    LAS float* scr = (LAS float*)(F.lds + F.wave * 8704);
    const int gw = F.bid * 8 + F.wave, NGW = F.G * 8;
    constexpr int NITEMS = DEPTH * (16 * 65 + 16 * 32 + 16 * 128 + 64 * 32 + 32);
    {
        TItem T0, T1; TRegs R0, R1;
        if (gw < NITEMS) { titem_decode(F, gw, T0); titem_load(T0, R0, F.lane); }
        for (int it = gw; it < NITEMS; it += NGW) {
            const bool more = it + NGW < NITEMS;
            if (more) { titem_decode(F, it + NGW, T1); titem_load(T1, R1, F.lane); }
            titem_store(T0, R0, scr, F.lane);
            if (more) { T0 = T1; R0 = R1; }
        }
    }
    f32x4 v0[4], v1[4];
    if (gw < MT) { const float* src = gw < MP ? F.x_prompt + (size_t)gw * D : F.x_sample + (size_t)(gw - MP) * D;
#pragma unroll
        for (int j = 0; j < 4; ++j) v0[j] = ((const f32x4*)src + F.lane)[64 * j]; }
    for (int m = gw; m < MT; m += NGW) {
        const int mn = m + NGW;
        if (mn < MT) { const float* src = mn < MP ? F.x_prompt + (size_t)mn * D : F.x_sample + (size_t)(mn - MP) * D;
#pragma unroll
            for (int j = 0; j < 4; ++j) v1[j] = ((const f32x4*)src + F.lane)[64 * j]; }
        u32x2* bo = (u32x2*)(F.xb + (size_t)m * D) + F.lane;
        float s = 0.f;
#pragma unroll
        for (int j = 0; j < 4; ++j) { const f32x4 v = v0[j]; u32x2 w; w.x = cvtpk(v[0], v[1]); w.y = cvtpk(v[2], v[3]); bo[64 * j] = w; s += (v[0] * v[0] + v[1] * v[1]) + (v[2] * v[2] + v[3] * v[3]); }
        s = wave_sum(s);
        if (m < MP) { if (F.lane < 16) F.rsp[(size_t)m * 16 + F.lane] = F.lane == 0 ? s : 0.f; }
        else F.rss[(size_t)(m - MP) * 64 + F.lane] = F.lane == 0 ? s : 0.f;
        if (mn < MT) {
#pragma unroll
            for (int j = 0; j < 4; ++j) v0[j] = v1[j]; }
    }
}

constexpr int L_AL = 0, L_B = 4096, L_TOT = 20736, L_BL = 22784, L_QT = 23040, L_KT = 32256, L_VT = 41472, L_ATT = 59904, L_SS = 69120;
__device__ __forceinline__ float logsig(float x) { return fminf(x, 0.f) - __logf(1.f + __expf(-fabsf(x))); }
__device__ __forceinline__ float rdlane(float v, int lane) { return __int_as_float(__builtin_amdgcn_readlane(__float_as_int(v), lane)); }
struct KvC { float w[16]; float bj; };
struct KvU { f32x4 alv; bf16_t qv[8], kv[8]; u32x4 vv[2]; };
__device__ __forceinline__ void gla_kv_loadc(const Frame& F, int l, int h, KvC& C) {
    const int j = F.tid & 63; const float* wg = F.w_gate + (size_t)l * 16 * 256 + h * 64 + j;
#pragma unroll
    for (int r = 0; r < 16; ++r) C.w[r] = wg[r * 256];
    C.bj = F.b_gate[l * 256 + h * 64 + j];
}
__device__ __forceinline__ void gla_kv_load(const Frame& F, int unit, KvU& U) {
    const int bh = unit >> 5, n = unit & 31, b = bh >> 2, h = bh & 3, row0 = b * SEQ + n * 64, tid = F.tid, j = tid & 63, cgp = F.wave;
    const bf16_t* zrow0 = F.z + (size_t)row0 * ZLD;
    const float* al = F.alow + (size_t)(row0 + cgp * 8) * 16;
    U.alv = (f32x4){0.f, 0.f, 0.f, 0.f}; if (F.lane < 32) U.alv = *(const f32x4*)(al + F.lane * 4);
#pragma unroll
    for (int i = 0; i < 8; ++i) { const bf16_t* zr = zrow0 + (size_t)(cgp * 8 + i) * ZLD + h * 64 + j; U.qv[i] = zr[ZQ]; U.kv[i] = zr[ZK]; }
#pragma unroll
    for (int pass = 0; pass < 2; ++pass) U.vv[pass] = *(const u32x4*)(zrow0 + (size_t)((tid >> 4) + pass * 32) * ZLD + ZV + h * 128 + (tid & 15) * 8);
}
__device__ __forceinline__ void gla_kv_unit(const Frame& F, int l, int unit, const KvC& C, const KvU& U) {
    const int tid = F.tid;
    LAS float* sTot = (LAS float*)(F.lds + L_TOT);
    LAS bf16_t* sQt = (LAS bf16_t*)(F.lds + L_QT); LAS bf16_t* sKt = (LAS bf16_t*)(F.lds + L_KT); LAS bf16_t* sKeT = (LAS bf16_t*)(F.lds + L_ATT); LAS bf16_t* sVT = (LAS bf16_t*)(F.lds + L_VT);
    const int j = tid & 63, cgp = F.wave;
    const f32x4 alv = U.alv; const float bj = C.bj;
    float loc[8]; float run = 0.f;
#pragma unroll
    for (int i = 0; i < 8; ++i) { float ga = bj;
#pragma unroll
        for (int r = 0; r < 16; ++r) ga += rdlane(alv[r & 3], i * 4 + (r >> 2)) * C.w[r];
        run += logsig(ga) * (1.0f / 16.0f); loc[i] = run; }
    sTot[cgp * 64 + j] = run;
#pragma unroll
    for (int pass = 0; pass < 2; ++pass) { const int vg = tid & 15, sidx = (tid >> 4) + pass * 32;
#pragma unroll
        for (int i = 0; i < 4; ++i) { sVT[(vg * 8 + 2 * i) * 72 + sidx] = (bf16_t)(U.vv[pass][i] & 0xffffu); sVT[(vg * 8 + 2 * i + 1) * 72 + sidx] = (bf16_t)(U.vv[pass][i] >> 16); } }
    __syncthreads();
    float off = 0.f, tot = 0.f;
#pragma unroll
    for (int g = 0; g < 8; ++g) { const float tv = sTot[g * 64 + j]; off += (g < cgp) ? tv : 0.f; tot += tv; }
    u32x4 kep;
#pragma unroll
    for (int i = 0; i < 8; i += 2) {
        const float b0 = off + loc[i], b1 = off + loc[i + 1];
        const float q0 = bf2f(U.qv[i]), q1 = bf2f(U.qv[i + 1]), k0 = bf2f(U.kv[i]), k1 = bf2f(U.kv[i + 1]);
        sQt[(cgp * 8 + i) * 72 + j] = f2bf(q0 * __expf(b0) * 0.125f); sQt[(cgp * 8 + i + 1) * 72 + j] = f2bf(q1 * __expf(b1) * 0.125f);
        sKt[(cgp * 8 + i) * 72 + j] = f2bf(k0 * __expf(-b0)); sKt[(cgp * 8 + i + 1) * 72 + j] = f2bf(k1 * __expf(-b1));
        kep[i >> 1] = cvtpk(k0 * __expf(tot - b0), k1 * __expf(tot - b1)); }
    *(LAS u32x4*)(sKeT + j * 72 + cgp * 8) = kep;
    if (cgp == 0) F.dec[unit * 64 + j] = __expf(tot);
    __syncthreads();
    const int wv = F.wave, fr = F.lane & 15, fq = F.lane >> 4;
    f32x4 acc[4];
#pragma unroll
    for (int nt = 0; nt < 4; ++nt) acc[nt] = (f32x4){0.f, 0.f, 0.f, 0.f};
#pragma unroll
    for (int ks = 0; ks < 2; ++ks) { const bf16x8 a = *(const LAS bf16x8*)(sVT + (wv * 16 + fr) * 72 + ks * 32 + fq * 8);
#pragma unroll
        for (int nt = 0; nt < 4; ++nt) { const bf16x8 bb = *(const LAS bf16x8*)(sKeT + (nt * 16 + fr) * 72 + ks * 32 + fq * 8); acc[nt] = __builtin_amdgcn_mfma_f32_16x16x32_bf16(a, bb, acc[nt], 0, 0, 0); } }
    { const int sr = tid >> 3, kg = tid & 7;
      *(u32x4*)(F.qt + (size_t)unit * 4096 + sr * 64 + kg * 8) = *(const LAS u32x4*)(sQt + sr * 72 + kg * 8);
      *(u32x4*)(F.kt + (size_t)unit * 4096 + sr * 64 + kg * 8) = *(const LAS u32x4*)(sKt + sr * 72 + kg * 8);
#pragma unroll
      for (int p = 0; p < 2; ++p) { const int id = tid + 512 * p, vc = id >> 3, ch = id & 7; *(u32x4*)(F.vt + (size_t)unit * 8192 + vc * 64 + ch * 8) = *(const LAS u32x4*)(sVT + vc * 72 + ch * 8); } }
    float* kvt = F.kvt + (size_t)unit * 8192;
#pragma unroll
    for (int nt = 0; nt < 4; ++nt)
#pragma unroll
        for (int jj = 0; jj < 4; ++jj) kvt[(wv * 16 + fq * 4 + jj) * 64 + nt * 16 + fr] = acc[nt][jj];
    __syncthreads();
}
struct OutU { u32x4 q16, k16, v16[2]; bf16x8 bs[4][2]; bf16_t gzr[4][4]; };
__device__ __forceinline__ void gla_out_load(const Frame& F, int unit, OutU& U) {
    const int bh = unit >> 5, n = unit & 31, b = bh >> 2, h = bh & 3, row0 = b * SEQ + n * 64;
    const bf16_t* zrow0 = F.z + (size_t)row0 * ZLD;
    const int w = F.wave, fr = F.lane & 15, fq = F.lane >> 4, mt = w >> 1, nt4 = (w & 1) * 4, sr = F.tid >> 3, kg = F.tid & 7;
    U.q16 = *(const u32x4*)(F.qt + (size_t)unit * 4096 + sr * 64 + kg * 8); U.k16 = *(const u32x4*)(F.kt + (size_t)unit * 4096 + sr * 64 + kg * 8);
#pragma unroll
    for (int p = 0; p < 2; ++p) { const int id = F.tid + 512 * p; U.v16[p] = *(const u32x4*)(F.vt + (size_t)unit * 8192 + (id >> 3) * 64 + (id & 7) * 8); }
    const bf16_t* stg = F.st + (size_t)unit * 8192;
#pragma unroll
    for (int q = 0; q < 4; ++q)
#pragma unroll
        for (int ks = 0; ks < 2; ++ks) U.bs[q][ks] = *(const bf16x8*)(stg + ((nt4 + q) * 16 + fr) * 64 + ks * 32 + fq * 8);
#pragma unroll
    for (int j = 0; j < 4; ++j)
#pragma unroll
        for (int q = 0; q < 4; ++q) U.gzr[j][q] = zrow0[(size_t)(mt * 16 + fq * 4 + j) * ZLD + ZG + h * 128 + (nt4 + q) * 16 + fr];
}
__device__ __forceinline__ void gla_out_unit_v3(const Frame& F, int l, int unit, const OutU& U, const float (&gnv)[4]) {
    const int bh = unit >> 5, n = unit & 31, b = bh >> 2, h = bh & 3, row0 = b * SEQ + n * 64;
    LAS float* sSS = (LAS float*)(F.lds + L_SS);
    LAS bf16_t* sQt = (LAS bf16_t*)(F.lds + L_QT); LAS bf16_t* sKt = (LAS bf16_t*)(F.lds + L_KT); LAS bf16_t* sVT = (LAS bf16_t*)(F.lds + L_VT); LAS bf16_t* sAtt = (LAS bf16_t*)(F.lds + L_ATT);
    const int w = F.wave, fr = F.lane & 15, fq = F.lane >> 4, mt = w >> 1, nt4 = (w & 1) * 4;
    { const int sr = F.tid >> 3, kg = F.tid & 7;
      *(LAS u32x4*)(sQt + sr * 72 + kg * 8) = U.q16; *(LAS u32x4*)(sKt + sr * 72 + kg * 8) = U.k16;
#pragma unroll
      for (int p = 0; p < 2; ++p) { const int id = F.tid + 512 * p; *(LAS u32x4*)(sVT + (id >> 3) * 72 + (id & 7) * 8) = U.v16[p]; } }
    __syncthreads();
#pragma unroll
    for (int q = 0; q < 2; ++q) { const int nt = (w & 1) * 2 + q;
        f32x4 acc = (f32x4){0.f, 0.f, 0.f, 0.f};
        if (nt <= mt) {
#pragma unroll
            for (int ks = 0; ks < 2; ++ks) { const bf16x8 a = *(const LAS bf16x8*)(sQt + (mt * 16 + fr) * 72 + ks * 32 + fq * 8); const bf16x8 bb = *(const LAS bf16x8*)(sKt + (nt * 16 + fr) * 72 + ks * 32 + fq * 8);
                acc = __builtin_amdgcn_mfma_f32_16x16x32_bf16(a, bb, acc, 0, 0, 0); } }
#pragma unroll
        for (int j = 0; j < 4; ++j) { const int c = mt * 16 + fq * 4 + j, s = nt * 16 + fr; sAtt[c * 72 + s] = f2bf(s <= c ? acc[j] : 0.f); } }
    __syncthreads();
    f32x4 o[4];
#pragma unroll
    for (int q = 0; q < 4; ++q) o[q] = (f32x4){0.f, 0.f, 0.f, 0.f};
#pragma unroll
    for (int ks = 0; ks < 2; ++ks) {
        const bf16x8 a1 = *(const LAS bf16x8*)(sAtt + (mt * 16 + fr) * 72 + ks * 32 + fq * 8); const bf16x8 a2 = *(const LAS bf16x8*)(sQt + (mt * 16 + fr) * 72 + ks * 32 + fq * 8);
#pragma unroll
        for (int q = 0; q < 4; ++q) { const int nt = nt4 + q;
            const bf16x8 bv = *(const LAS bf16x8*)(sVT + (nt * 16 + fr) * 72 + ks * 32 + fq * 8);
            o[q] = __builtin_amdgcn_mfma_f32_16x16x32_bf16(a1, bv, o[q], 0, 0, 0); o[q] = __builtin_amdgcn_mfma_f32_16x16x32_bf16(a2, U.bs[q][ks], o[q], 0, 0, 0); } }
    float p[4];
#pragma unroll
    for (int j = 0; j < 4; ++j) { float s = 0.f;
#pragma unroll
        for (int q = 0; q < 4; ++q) s += o[q][j] * o[q][j];
        s += __shfl_xor(s, 1); s += __shfl_xor(s, 2); s += __shfl_xor(s, 4); s += __shfl_xor(s, 8); p[j] = s; }
    if (fr == 0) {
#pragma unroll
        for (int j = 0; j < 4; ++j) sSS[(w & 1) * 64 + mt * 16 + fq * 4 + j] = p[j]; }
    __syncthreads();
#pragma unroll
    for (int j = 0; j < 4; ++j) { const int c = mt * 16 + fq * 4 + j; const float rs = rsqrtf((sSS[c] + sSS[64 + c]) * (1.0f / 128.0f) + EPS);
#pragma unroll
        for (int q = 0; q < 4; ++q) { const int vcol = (nt4 + q) * 16 + fr; const float gz = bf2f(U.gzr[j][q]);
            const float val = o[q][j] * rs * gnv[q] * (gz / (1.f + __expf(-gz)));
            F.mix[(size_t)(row0 + c) * D + h * 128 + vcol] = f2bf(val); } }
    __syncthreads();
}
__device__ __forceinline__ void gla_scan_elem(const Frame& F, int l, int e) {
    const int bh = e >> 12, idx = (e & 4095) * 2, k = idx & 63, vcol = idx >> 6;
    const float* kv = F.kvt + (size_t)bh * 32 * 8192 + idx; const float* dc = F.dec + bh * 32 * 64 + k; bf16_t* st = F.st + (size_t)bh * 32 * 8192 + idx;
    f32x2 S = (f32x2){0.f, 0.f};
#pragma unroll 8
    for (int n = 0; n < 32; ++n) { *(unsigned*)(st + (size_t)n * 8192) = cvtpk(S[0], S[1]);
        const f32x2 d = *(const f32x2*)(dc + n * 64), x = *(const f32x2*)(kv + (size_t)n * 8192); S = d * S + x; }
    float* o = F.out + O_GLAP + ((size_t)l * 32 + bh) * 8192 + k * 128 + vcol;
    o[0] = S[0]; o[128] = S[1];
}
__device__ __forceinline__ void gla_scan(const Frame& F, int l) {
    if (F.G == 256) { const int b = F.bid & 7, j = F.bid >> 3; gla_scan_elem(F, l, (b * 4 + (j >> 3)) * 4096 + (j & 7) * 512 + F.tid); }
    else for (int e = F.bid * 512 + F.tid; e < 32 * 4096; e += F.G * 512) gla_scan_elem(F, l, e);
}
__device__ __forceinline__ void gla_decode_unit(const Frame& F, int l, int unit) {
    const int s = unit >> 2, h = unit & 3, row = MP + s, tid = F.tid;
    const bf16_t* zrow = F.z + (size_t)row * ZLD;
    LAS float* sA = (LAS float*)(F.lds); LAS float* sQ = sA + 64; LAS float* sK = sA + 128; LAS float* sO = sA + 192; LAS float* sRed = sA + 192 + 512;
    const int v = tid & 127, kg = tid >> 7;
    const size_t soff = (((size_t)l * 128 + s) * 4 + h) * 8192;
    const float* S0 = F.state_gla + soff; float* Sn = F.out + O_GLAS + soff;
    float s0r[16];
#pragma unroll
    for (int i = 0; i < 16; ++i) s0r[i] = S0[(kg * 16 + i) * 128 + v];
    const float vv = bf2f(zrow[ZV + h * 128 + v]); const float gzv = bf2f(zrow[ZG + h * 128 + v]);
    if (tid < 64) { const int j = tid; const float* wg = F.w_gate + (size_t)l * 16 * 256 + h * 64 + j; float ga = F.b_gate[l * 256 + h * 64 + j];
#pragma unroll
        for (int r = 0; r < 16; ++r) ga += F.alow[(size_t)row * 16 + r] * wg[r * 256];
        sA[j] = __expf(logsig(ga) * (1.0f / 16.0f)); sQ[j] = bf2f(zrow[ZQ + h * 64 + j]); sK[j] = bf2f(zrow[ZK + h * 64 + j]); }
    __syncthreads();
    float po = 0.f;
#pragma unroll 16
    for (int i = 0; i < 16; ++i) { const int k = kg * 16 + i; const float sn = sA[k] * s0r[i] + sK[k] * vv; Sn[k * 128 + v] = sn; po += sQ[k] * sn; }
    sO[kg * 128 + v] = po;
    __syncthreads();
    float o = 0.f;
    if (tid < 128) { o = 0.125f * ((sO[v] + sO[128 + v]) + (sO[256 + v] + sO[384 + v])); const float sq = wave_sum(o * o); if (F.lane == 0) sRed[F.wave] = sq; }
    __syncthreads();
    if (tid < 128) { const float rs = rsqrtf((sRed[0] + sRed[1]) * (1.0f / 128.0f) + EPS); const float gz = gzv;
        F.mix[(size_t)row * D + h * 128 + v] = f2bf(o * rs * F.gla_norm_g[l * 128 + v] * (gz / (1.f + __expf(-gz)))); }
    __syncthreads();
}
constexpr int L_U = 0, L_P = 40448;
struct PoolB { bf16x8 b[4][4]; float sc[4]; };
__device__ __forceinline__ void pool_load_b(const Frame& F, int l, int g, PoolB& P) {
    const int w = F.wave, fr = F.lane & 15, fq = F.lane >> 4, nt4 = (w & 1) * 4;
    const bf16_t* pw = wptr(F, l, W_POOL) + g * 16384;
#pragma unroll
    for (int q = 0; q < 4; ++q) {
#pragma unroll
        for (int ks = 0; ks < 4; ++ks) P.b[q][ks] = *(const bf16x8*)(pw + ((nt4 + q) * 16 + fr) * 128 + ks * 32 + fq * 8);
        P.sc[q] = F.pool_scale[l * 512 + g * 128 + (nt4 + q) * 16 + fr]; }
}
__device__ __forceinline__ void pool_mma_store(const Frame& F, int g, int row0, const PoolB& P) {
    LAS bf16_t* sP = (LAS bf16_t*)(F.lds + L_P);
    const int w = F.wave, fr = F.lane & 15, fq = F.lane >> 4, mt = w >> 1, nt4 = (w & 1) * 4;
    f32x4 acc[4];
#pragma unroll
    for (int q = 0; q < 4; ++q) acc[q] = (f32x4){0.f, 0.f, 0.f, 0.f};
#pragma unroll
    for (int ks = 0; ks < 4; ++ks) { const bf16x8 a = *(const LAS bf16x8*)(sP + (mt * 16 + fr) * 136 + ks * 32 + fq * 8);
#pragma unroll
        for (int q = 0; q < 4; ++q) acc[q] = __builtin_amdgcn_mfma_f32_16x16x32_bf16(a, P.b[q][ks], acc[q], 0, 0, 0); }
#pragma unroll
    for (int q = 0; q < 4; ++q) { const int d = (nt4 + q) * 16 + fr;
#pragma unroll
        for (int j = 0; j < 4; ++j) F.mix[(size_t)(row0 + mt * 16 + fq * 4 + j) * D + 512 + g * 128 + d] = f2bf(acc[q][j] * P.sc[q]); }
}
struct PoolU { u32x4 uv[3]; };
__device__ __forceinline__ void pool_prompt_load(const Frame& F, int unit, PoolU& U) {
    const int g = unit & 3, bn = unit >> 2, n = bn & 31, b = bn >> 5, t0 = n * 64, tid = F.tid, cg8 = tid & 15;
#pragma unroll
    for (int pass = 0; pass < 3; ++pass) { const int i = (tid >> 4) + pass * 32, t = t0 - 15 + i;
        U.uv[pass] = (u32x4){0u, 0u, 0u, 0u}; if (i < 79 && t >= 0) U.uv[pass] = *(const u32x4*)(F.z + (size_t)(b * SEQ + t) * ZLD + ZU + g * 128 + cg8 * 8); }
}
__device__ __forceinline__ void pool_prompt_unit(const Frame& F, int l, int unit, const PoolU& U, const PoolB& PB) {
    const int g = unit & 3, bn = unit >> 2, n = bn & 31, b = bn >> 5, t0 = n * 64, row0 = b * SEQ + t0, tid = F.tid;
    LAS float* sU = (LAS float*)(F.lds + L_U); LAS bf16_t* sP = (LAS bf16_t*)(F.lds + L_P);
    { const int cg8 = tid & 15;
#pragma unroll
      for (int pass = 0; pass < 3; ++pass) { const int i = (tid >> 4) + pass * 32; if (i < 79) {
          { const u32x4 uu = U.uv[pass]; *(LAS f32x4*)(sU + i * 128 + cg8 * 8) = (f32x4){bflo(uu.x), bfhi(uu.x), bflo(uu.y), bfhi(uu.y)}; *(LAS f32x4*)(sU + i * 128 + cg8 * 8 + 4) = (f32x4){bflo(uu.z), bfhi(uu.z), bflo(uu.w), bfhi(uu.w)}; } } } }
    __syncthreads();
    { const int c = tid & 127, tg = tid >> 7, wdw = 2 << g;
      float s = 0.f; const int i0 = tg * 16 + 15;
      for (int d = 1; d < wdw; ++d) s += sU[(i0 - d) * 128 + c];
#pragma unroll 4
      for (int tt = 0; tt < 16; ++tt) { const int i = i0 + tt; const float u = sU[i * 128 + c]; s += u; const int t = t0 + tg * 16 + tt; const float cnt = (float)min(wdw, t + 1);
          sP[(tg * 16 + tt) * 136 + c] = f2bf(s / cnt - u); s -= sU[(i - wdw + 1) * 128 + c]; }
      if (n == 31 && tid < 128) {
#pragma unroll
          for (int j = 0; j < 15; ++j) F.out[O_POOLP + (((size_t)l * 8 + b) * 15 + j) * 512 + g * 128 + c] = sU[(64 + j) * 128 + c]; } }
    __syncthreads();
    pool_mma_store(F, g, row0, PB);
    __syncthreads();
}
__device__ __forceinline__ void pool_sample_unit(const Frame& F, int l, int unit) {
    const int g = unit & 3, sblk = unit >> 2, tid = F.tid, c = tid & 127, sg = tid >> 7, wdw = 2 << g;
    LAS bf16_t* sP = (LAS bf16_t*)(F.lds + L_P);
    const int w = F.wave, fr = F.lane & 15, fq = F.lane >> 4;
    bf16x8 bfr[4];
    { const bf16_t* pw = wptr(F, l, W_POOL) + g * 16384;
#pragma unroll
      for (int ks = 0; ks < 4; ++ks) bfr[ks] = *(const bf16x8*)(pw + (w * 16 + fr) * 128 + ks * 32 + fq * 8); }
    const float sc = F.pool_scale[l * 512 + g * 128 + w * 16 + fr];
    float pv[4][15]; float uv[4];
#pragma unroll
    for (int i = 0; i < 4; ++i) { const int s = sblk * 16 + sg * 4 + i;
        const float* sp = F.state_pool + (((size_t)l * 128 + s) * 15) * 512 + g * 128 + c;
        uv[i] = bf2f(F.z[(size_t)(MP + s) * ZLD + ZU + g * 128 + c]);
#pragma unroll
        for (int j = 0; j < 15; ++j) pv[i][j] = sp[j * 512]; }
#pragma unroll
    for (int i = 0; i < 4; ++i) { const int sl = sg * 4 + i, s = sblk * 16 + sl;
        float* so = F.out + O_POOLS + (((size_t)l * 128 + s) * 15) * 512 + g * 128 + c;
        float sum = uv[i];
#pragma unroll
        for (int j = 0; j < 15; ++j) { if (j >= 16 - wdw) sum += pv[i][j]; if (j >= 1) so[(j - 1) * 512] = pv[i][j]; }
        so[14 * 512] = uv[i];
        sP[sl * 136 + c] = f2bf(sum / (float)wdw - uv[i]); }
    __syncthreads();
    f32x4 acc = (f32x4){0.f, 0.f, 0.f, 0.f};
#pragma unroll
    for (int ks = 0; ks < 4; ++ks) { const bf16x8 a = *(const LAS bf16x8*)(sP + fr * 136 + ks * 32 + fq * 8); acc = __builtin_amdgcn_mfma_f32_16x16x32_bf16(a, bfr[ks], acc, 0, 0, 0); }
#pragma unroll
    for (int j = 0; j < 4; ++j) F.mix[(size_t)(MP + sblk * 16 + fq * 4 + j) * D + 512 + g * 128 + w * 16 + fr] = f2bf(acc[j] * sc);
    __syncthreads();
}

__device__ __forceinline__ int gla_unit_at(int bid, int G, int k) { if (G != 256) return bid + k * G; const int b = bid & 7, j = bid >> 3; return ((b * 4 + (j & 3)) << 5) | ((j >> 2) * 4 + k); }
__device__ __forceinline__ int pool_unit_at(int bid, int G, int k) { if (G != 256) return bid + k * G; const int b = bid & 7, j = bid >> 3; return ((b * 32 + (j >> 2) * 4 + k) << 2) | (j & 3); }
__device__ __forceinline__ int units_of(int bid, int G) { return G == 256 ? 4 : (1024 - bid + G - 1) / G; }

__global__ void __launch_bounds__(512, 2) hymba_fwd(Args args) {
    extern __shared__ __attribute__((aligned(16))) unsigned char lds_raw[];
    cg::grid_group grid = cg::this_grid();
    typedef const __attribute__((address_space(4))) Args* KArgs;
    const KArgs ap0 = (KArgs)__builtin_amdgcn_kernarg_segment_ptr();
    const int ph_lo = ap0->ph_lo, ph_hi = ap0->ph_hi, coop = ap0->coop;
    for (int u = threadIdx.x; u < (LDS_BYTES - 131072) / 4; u += 512) ((LAS unsigned*)((LAS unsigned char*)lds_raw + 131072))[u] = 0u;
    __syncthreads();
    if (coop) (void)xcd_barrier_post((unsigned*)(ap0->ws + WS_CTL), (volatile LAS unsigned*)((LAS unsigned char*)lds_raw + MISC_OFF) + 8);
#ifndef PROBE_REP
#define PROBE_REP 0
#endif
    for (int ph = ph_lo; ph < ph_hi; ++ph) {
    const int sub_ = (ph == 0) ? -1 : (ph - 1) % 7; const int nrep = (ph == NPHASE - 1) ? 1 : ((ph == 0) ? ((PROBE_REP & 1) ? 2 : 1) : ((sub_ == 0 && (PROBE_REP & 2)) || (sub_ == 1 && (PROBE_REP & 4)) || (sub_ == 2 && (PROBE_REP & 8)) || (sub_ == 3 && (PROBE_REP & 16)) || (sub_ == 5 && (PROBE_REP & 32))) ? 2 : 1);
    for (int rep_ = 0; rep_ < nrep; ++rep_) {
    int tid_ = threadIdx.x; asm volatile("" : "+v"(tid_));
    KArgs ap = ap0; asm volatile("" : "+s"(ap));
    unsigned char* ws_ = ap->ws; float* out_ = ap->out;
    Frame F;
    F.lds = (LAS unsigned char*)lds_raw; F.tid = tid_; F.lane = F.tid & 63; F.wave = __builtin_amdgcn_readfirstlane(F.tid >> 6); F.G = gridDim.x; F.bid = blockIdx.x;
    F.x_prompt = ap->in[0]; F.x_sample = ap->in[1]; F.state_gla = ap->in[2]; F.state_pool = ap->in[3]; F.norm1_g = ap->in[4]; F.w_in = ap->in[5]; F.w_gate = ap->in[6]; F.b_gate = ap->in[7];
    F.gla_norm_g = ap->in[8]; F.pool_w = ap->in[9]; F.pool_scale = ap->in[10]; F.w_out = ap->in[11]; F.norm2_g = ap->in[12]; F.w_up = ap->in[13]; F.w_down = ap->in[14]; F.final_g = ap->in[15];
    F.out = out_; F.ws = ws_;
    F.rsp = (float*)(F.ws + WS_RSP); F.rss = (float*)(F.ws + WS_RSS); F.alow = (float*)(F.ws + WS_ALOW); F.dec = (float*)(F.ws + WS_DEC); F.kvt = (float*)(F.ws + WS_KVT);
    F.xb = (bf16_t*)(F.ws + WS_XB); F.z = (bf16_t*)(F.ws + WS_Z); F.mix = (bf16_t*)(F.ws + WS_MIX); F.hid = (bf16_t*)(F.ws + WS_HID); F.st = (bf16_t*)(F.ws + WS_ST);
    F.qt = (bf16_t*)(F.ws + WS_QKV); F.kt = F.qt + (size_t)1024 * 4096; F.vt = F.kt + (size_t)1024 * 4096;
        if (ph == 0) {
            p0_prologue(F);
        } else if (ph == NPHASE - 1) {
            const int gw = F.bid * 8 + F.wave, NGW = F.G * 8;
            for (int m = gw; m < MT; m += NGW) { const u32x2* xr = (const u32x2*)(F.xb + (size_t)m * D) + F.lane; f32x4* yo = (f32x4*)(F.out + (size_t)m * D) + F.lane; const f32x4* gr = (const f32x4*)F.final_g + F.lane;
                const float part = m < MP ? (F.lane < 16 ? F.rsp[((size_t)8 * MP + m) * 16 + F.lane] : 0.f) : F.rss[((size_t)8 * 128 + (m - MP)) * 64 + F.lane];
                const float rs = rsqrtf(wave_sum(part) * (1.0f / D) + EPS);
#pragma unroll
                for (int j = 0; j < 4; ++j) { const u32x2 xw = xr[64 * j]; f32x4 v = (f32x4){bflo(xw.x), bfhi(xw.x), bflo(xw.y), bfhi(xw.y)}; v = v * rs * gr[64 * j]; yo[64 * j] = v; } }
        } else {
            const int l = (ph - 1) / 7, sub = (ph - 1) % 7;
            if (sub == 0) {
                const float* ssp = F.rsp + (size_t)(2 * l) * MP * 16; const float* sss = F.rss + (size_t)(2 * l) * 128 * 64;
                { pg8::Gemm g{F.xb, wptr(F, l, W_IN), MP, ZLD, D}; pg8::StaticOrder S; S.init(MP, ZLD, F.G, F.bid);
                  pg8::EpiScaleBf16<0> E{F.z, ZLD, ssp};
                  pg8::gemm_phase<pg8::EpiScaleBf16<0>, pg8::StaticOrder, true, true>(F.lds, g, S, E, F.tid); }
                for (int u = F.bid; u < 129 + 128; u += F.G) {
                    if (u < 128) { SkAlow<16> E{F.alow + (size_t)u * 128 * 16, ssp + (size_t)u * 128 * 16}; skinny_unit<8, 2>(F.lds, F.xb + (size_t)u * 128 * D, D, wptr(F, l, W_IN) + (size_t)2048 * D, D, E, F.tid); }
                    else if (u == 128) { SkAlow<64> E{F.alow + (size_t)u * 128 * 16, sss}; skinny_unit<8, 2>(F.lds, F.xb + (size_t)u * 128 * D, D, wptr(F, l, W_IN) + (size_t)2048 * D, D, E, F.tid); }
                    else { const int j = u - 129; SkScaleBf16<0> E{F.z + (size_t)MP * ZLD + j * 16, ZLD, sss}; skinny_unit<8, 2>(F.lds, F.xb + (size_t)MP * D, D, wptr(F, l, W_IN) + (size_t)j * 16 * D, D, E, F.tid); }
                }
            } else if (sub == 1) {
                { KvC C; KvU U0; const int nu = units_of(F.bid, F.G);
                  const int u0 = gla_unit_at(min(F.bid, 1023), F.G, 0); gla_kv_loadc(F, l, (u0 >> 5) & 3, C); gla_kv_load(F, u0, U0);
                  for (int k = 0; k < nu; ++k) { const int u = gla_unit_at(F.bid, F.G, k); if (F.G != 256) gla_kv_loadc(F, l, (u >> 5) & 3, C);
                      KvU U1; if (k + 1 < nu) gla_kv_load(F, gla_unit_at(F.bid, F.G, k + 1), U1); else U1 = U0;
                      gla_kv_unit(F, l, u, C, U0); U0 = U1; } }
            } else if (sub == 2) {
                { PoolB PB; PoolU U0; const int nu = units_of(F.bid, F.G);
                  const int u0 = pool_unit_at(min(F.bid, 1023), F.G, 0); pool_load_b(F, l, u0 & 3, PB); pool_prompt_load(F, u0, U0);
                  gla_scan(F, l);
                  for (int k = 0; k < nu; ++k) { const int u = pool_unit_at(F.bid, F.G, k); if (F.G != 256) pool_load_b(F, l, u & 3, PB);
                      PoolU U1; if (k + 1 < nu) pool_prompt_load(F, pool_unit_at(F.bid, F.G, k + 1), U1); else U1 = U0;
                      pool_prompt_unit(F, l, u, U0, PB); U0 = U1; } }
                for (int u = 1024 + F.bid; u < 1024 + 32 + 512; u += F.G) {
                    if (u < 1056) pool_sample_unit(F, l, u - 1024); else gla_decode_unit(F, l, u - 1056);
                }
            } else if (sub == 3) {
                { OutU U0; float gnv[4];
#pragma unroll
                  for (int q = 0; q < 4; ++q) gnv[q] = F.gla_norm_g[l * 128 + ((F.wave & 1) * 4 + q) * 16 + (F.lane & 15)];
                  const int nu = units_of(F.bid, F.G); gla_out_load(F, gla_unit_at(min(F.bid, 1023), F.G, 0), U0);
                  for (int k = 0; k < nu; ++k) { const int u = gla_unit_at(F.bid, F.G, k); OutU U1; if (k + 1 < nu) gla_out_load(F, gla_unit_at(F.bid, F.G, k + 1), U1); else U1 = U0;
                      gla_out_unit_v3(F, l, u, U0, gnv); U0 = U1; } }
            } else if (sub == 4) {
                float* ssp = F.rsp + (size_t)(2 * l + 1) * MP * 16; float* sss = F.rss + (size_t)(2 * l + 1) * 128 * 64;
                { pg8::Gemm g{F.mix, wptr(F, l, W_OUT), MP, D, D}; pg8::StaticOrder S; S.init(MP, D, F.G, F.bid);
                  pg8::EpiRes E{F.xb, ssp};
                  pg8::gemm_phase<pg8::EpiRes, pg8::StaticOrder, true, true>(F.lds, g, S, E, F.tid); }
                for (int uu = F.bid; uu < 256; uu += F.G) { const int u = uu & 63, r0 = MP + (uu >> 6) * 32; SkRes E{F.xb + (size_t)r0 * D + u * 16, sss + (size_t)(r0 - MP) * 64, u}; skinny_unit<2, 4>(F.lds, F.mix + (size_t)r0 * D, D, wptr(F, l, W_OUT) + (size_t)u * 16 * D, D, E, F.tid); }
            } else if (sub == 5) {
                const float* ssp = F.rsp + (size_t)(2 * l + 1) * MP * 16; const float* sss = F.rss + (size_t)(2 * l + 1) * 128 * 64;
                { pg8::Gemm g{F.xb, wptr(F, l, W_UP), MP, FF, D}; pg8::StaticOrder S; S.init(MP, FF, F.G, F.bid);
                  pg8::EpiScaleBf16<1> E{F.hid, FF, ssp};
                  pg8::gemm_phase<pg8::EpiScaleBf16<1>, pg8::StaticOrder, true, true>(F.lds, g, S, E, F.tid); }
                for (int u = F.bid; u < 256; u += F.G) { SkScaleBf16<1> E{F.hid + (size_t)MP * FF + u * 16, FF, sss}; skinny_unit<8, 2>(F.lds, F.xb + (size_t)MP * D, D, wptr(F, l, W_UP) + (size_t)u * 16 * D, D, E, F.tid); }
            } else {
                float* ssp = F.rsp + (size_t)(2 * l + 2) * MP * 16; float* sss = F.rss + (size_t)(2 * l + 2) * 128 * 64;
                { pg8::Gemm g{F.hid, wptr(F, l, W_DOWN), MP, D, FF}; pg8::StaticOrder S; S.init(MP, D, F.G, F.bid);
                  pg8::EpiRes E{F.xb, ssp};
                  pg8::gemm_phase<pg8::EpiRes, pg8::StaticOrder, true, true>(F.lds, g, S, E, F.tid); }
                for (int uu = F.bid; uu < 256; uu += F.G) { const int u = uu & 63, r0 = MP + (uu >> 6) * 32; SkRes E{F.xb + (size_t)r0 * D + u * 16, sss + (size_t)(r0 - MP) * 64, u}; skinny_unit<2, 8>(F.lds, F.hid + (size_t)r0 * FF, FF, wptr(F, l, W_DOWN) + (size_t)u * 16 * FF, FF, E, F.tid); }
            }
        }
        }
        if (ph + 1 < ph_hi) { if (coop) { if (ph == 0) grid.sync(); else { KArgs apb = ap0; asm volatile("" : "+s"(apb)); XcdBarrier xbar; xbar.bar = (unsigned*)(apb->ws + WS_CTL); xbar.x = xb_xcc_id(); xbar.st = (volatile LAS unsigned*)((LAS unsigned char*)lds_raw + MISC_OFF) + 8; xcd_barrier(xbar); if (PROBE_REP & 64) xcd_barrier(xbar); } } }
    }
}

#ifndef ONE_LAUNCH
#define ONE_LAUNCH 1
#endif
extern "C" void kernel_launch(void* const* d_in, const int* in_sizes, int n_in, void* d_out, int out_size, void* d_ws, size_t ws_size, hipStream_t stream) {
    static int grid = 0;
    if (grid == 0) {
        if (n_in != 16 || ws_size < WS_END) { fprintf(stderr, "kernel_launch: need 16 inputs and >= %zu bytes of workspace (got %d, %zu)\n", (size_t)WS_END, n_in, ws_size); grid = -1; return; }
        int dev = 0, cus = 0, per_cu = 0;
        hipGetDevice(&dev); hipDeviceGetAttribute(&cus, hipDeviceAttributeMultiprocessorCount, dev);
        if (hipFuncSetAttribute((const void*)hymba_fwd, hipFuncAttributeMaxDynamicSharedMemorySize, LDS_BYTES) != hipSuccess) { fprintf(stderr, "kernel_launch: hipFuncSetAttribute failed\n"); grid = -1; return; }
        if (hipOccupancyMaxActiveBlocksPerMultiprocessor(&per_cu, (const void*)hymba_fwd, 512, LDS_BYTES) != hipSuccess || per_cu < 1) { fprintf(stderr, "kernel_launch: occupancy query says %d\n", per_cu); per_cu = 1; }
        (void)hipGetLastError();
        grid = cus;
    }
    if (grid < 0) return;
    if (hipMemsetAsync((char*)d_ws + WS_CTL, 0, CTL_ZERO_BYTES, stream) != hipSuccess) { fprintf(stderr, "kernel_launch: hipMemsetAsync failed\n"); return; }
    Args a{};
    for (int i = 0; i < 16; ++i) a.in[i] = (const float*)d_in[i];
    a.out = (float*)d_out; a.ws = (unsigned char*)d_ws;
#if ONE_LAUNCH
    a.ph_lo = 0; a.ph_hi = NPHASE; a.coop = 1;
    void* kargs[] = {&a};
    hipError_t e = hipLaunchCooperativeKernel((const void*)hymba_fwd, dim3(grid), dim3(512), kargs, LDS_BYTES, stream);
    if (e != hipSuccess) fprintf(stderr, "cooperative launch failed: %s (grid %d)\n", hipGetErrorString(e), grid);
#else
    for (int ph = 0; ph < NPHASE; ++ph) { a.ph_lo = ph; a.ph_hi = ph + 1; a.coop = 0; hipLaunchKernelGGL(hymba_fwd, dim3(grid), dim3(512), LDS_BYTES, stream, a); }
#endif
}
```
